# Optimizing an MI355X kernel written in HIP

```python
import jax, jax.numpy as jnp
from jax import lax
import numpy as np

D_MODEL = 2048
BATCH = 4
SEQ = 4096
DEPTH = 2

GRID_W = 64
CTX_LEN = 256
N_MOD = 9
D_FF = 5632
W_RG = 2048
RG_BLOCKS = 16
RG_BW = W_RG // RG_BLOCKS
RG_CONV = 4
RG_PAD_LO = 2
RG_C = 8.0
W_SC = 2048
SC_CONV = 3
SC_PAD_LO = 1
LN_EPS = 1e-5
ALPHA = (2 * DEPTH) ** 0.25
BETA = (8 * DEPTH) ** -0.25
PROJ_SIZES = (W_RG, W_RG, W_SC, W_SC, W_SC, D_MODEL, D_MODEL)
PROJ_W = sum(PROJ_SIZES)
PROJ_SPLITS = tuple(int(v) for v in np.cumsum(PROJ_SIZES)[:-1])

kernel_name = "hybrid_rglru_shortconv_macaron_deepnorm_dit"


def layer_norm(x, g, b):
    xf = x.astype(jnp.float32)
    mu = jnp.mean(xf, axis=-1, keepdims=True)
    var = jnp.mean(jnp.square(xf - mu), axis=-1, keepdims=True)
    return ((xf - mu) * lax.rsqrt(var + LN_EPS) * g.astype(jnp.float32) + b.astype(jnp.float32)).astype(x.dtype)


def modulate(x, shift, scale):
    return x * (1 + scale) + shift


def swiglu(h, w_in, w_out):
    g, u = jnp.split(h @ w_in, 2, axis=-1)
    return (jax.nn.silu(g) * u) @ w_out


def ffn_sublayer(x, shift, scale, gate, w_in, w_out, ln_g, ln_b):
    y = swiglu(modulate(x, shift, scale), w_in, w_out)
    return layer_norm(ALPHA * x + 0.5 * gate * y, ln_g, ln_b)


def dwconv(u, w, pad_lo):
    k_w = w.shape[0]
    t = u.shape[-2]
    pad = [(0, 0)] * (u.ndim - 2) + [(pad_lo, k_w - 1 - pad_lo), (0, 0)]
    up = jnp.pad(u, pad)
    return sum(up[..., k:k + t, :] * w[k] for k in range(k_w))


def conv_latent(u, w, pad_lo):
    b, s, ch = u.shape
    rows = s // GRID_W
    return dwconv(u.reshape(b, rows, GRID_W, ch), w, pad_lo).reshape(b, s, ch)


def _lin_combine(e1, e2):
    a1, v1 = e1
    a2, v2 = e2
    return a1 * a2, a2 * v1 + v2


def rglru_scan(u, w_gate, b_gate, lam, h0, reverse):
    b, t, w = u.shape
    ub = u.reshape(b, t, RG_BLOCKS, RG_BW)
    logits = jnp.einsum("bthi,ghij->gbthj", ub, w_gate).reshape(2, b, t, w) + b_gate[:, None, None, :]
    gates = jax.nn.sigmoid(logits)
    r, i = gates[0], gates[1]
    log_a = RG_C * r * jax.nn.log_sigmoid(lam)
    a = jnp.exp(log_a)
    v = jnp.sqrt(-jnp.expm1(2 * log_a)) * (i * u)
    entry = -1 if reverse else 0
    final = 0 if reverse else -1
    v = v.at[:, entry].add(a[:, entry] * h0)
    _, h = lax.associative_scan(_lin_combine, (a, v), reverse=reverse, axis=1)
    return h, h[:, final]


def rg_branch(u_x, conv, rg_conv_w, rg_conv_b, rg_gate_w, rg_gate_b, rg_lam, h0_f, h0_b):
    xc = conv(u_x, rg_conv_w, RG_PAD_LO) + rg_conv_b
    h_f, hT_f = rglru_scan(xc, rg_gate_w[0], rg_gate_b[0], rg_lam[0], h0_f, reverse=False)
    h_b, hT_b = rglru_scan(xc, rg_gate_w[1], rg_gate_b[1], rg_lam[1], h0_b, reverse=True)
    return h_f + h_b, hT_f, hT_b


def mixer_out(proj, h_rg, conv, sc_conv_w, w_rg_out, w_sc_out, b_merge, w_o):
    _, rg_gate, sc_b, sc_c, sc_x, g_rg, g_sc = jnp.split(proj, PROJ_SPLITS, axis=-1)
    y_rg = (h_rg * jax.nn.gelu(rg_gate)) @ w_rg_out
    y_sc = (sc_b * conv(sc_c * sc_x, sc_conv_w, SC_PAD_LO)) @ w_sc_out
    merged = jax.nn.sigmoid(g_rg + b_merge[0]) * y_rg + jax.nn.sigmoid(g_sc + b_merge[1]) * y_sc
    return merged @ w_o


def setup_inputs(seed: int = 0) -> dict:
    key = jax.random.key(seed)
    ks = jax.random.split(key, 24)

    def nrm(k, shape, scale):
        return jax.random.normal(k, shape, jnp.float32) * scale

    u = jax.random.uniform(ks[17], (DEPTH, 2, W_RG), jnp.float32, 0.81, 0.998)
    a0 = u ** (1.0 / RG_C)
    rg_lam = jnp.log(a0) - jnp.log1p(-a0)
    return {
        "x": nrm(ks[0], (BATCH, SEQ, D_MODEL), 1.0),
        "c": nrm(ks[1], (BATCH, D_MODEL), 1.0),
        "ctx": nrm(ks[2], (BATCH, CTX_LEN, D_MODEL), 1.0),
        "c_ctx": nrm(ks[3], (D_MODEL,), 1.0),
        "w_mod": nrm(ks[4], (DEPTH, D_MODEL, N_MOD * D_MODEL), 0.5 * D_MODEL ** -0.5),
        "b_mod": nrm(ks[5], (DEPTH, N_MOD * D_MODEL), 0.02),
        "ln_g": 1.0 + nrm(ks[6], (DEPTH, 3, D_MODEL), 0.02),
        "ln_b": nrm(ks[7], (DEPTH, 3, D_MODEL), 0.02),
        "ffn1_w_in": nrm(ks[8], (DEPTH, D_MODEL, 2 * D_FF), D_MODEL ** -0.5),
        "ffn1_w_out": nrm(ks[9], (DEPTH, D_FF, D_MODEL), BETA * D_FF ** -0.5),
        "ffn2_w_in": nrm(ks[10], (DEPTH, D_MODEL, 2 * D_FF), D_MODEL ** -0.5),
        "ffn2_w_out": nrm(ks[11], (DEPTH, D_FF, D_MODEL), BETA * D_FF ** -0.5),
        "w_in": nrm(ks[12], (DEPTH, D_MODEL, PROJ_W), D_MODEL ** -0.5),
        "rg_conv_w": nrm(ks[13], (DEPTH, RG_CONV, W_RG), RG_CONV ** -0.5),
        "rg_conv_b": nrm(ks[14], (DEPTH, W_RG), 0.02),
        "rg_gate_w": nrm(ks[15], (DEPTH, 2, 2, RG_BLOCKS, RG_BW, RG_BW), RG_BW ** -0.5),
        "rg_gate_b": nrm(ks[16], (DEPTH, 2, 2, W_RG), 0.02),
        "rg_lam": rg_lam,
        "sc_conv_w": nrm(ks[18], (DEPTH, SC_CONV, W_SC), SC_CONV ** -0.5),
        "w_rg_out": nrm(ks[19], (DEPTH, W_RG, D_MODEL), W_RG ** -0.5),
        "w_sc_out": nrm(ks[20], (DEPTH, W_SC, D_MODEL), W_SC ** -0.5),
        "b_merge": nrm(ks[21], (DEPTH, 2, D_MODEL), 0.02),
        "w_o": nrm(ks[22], (DEPTH, D_MODEL, D_MODEL), BETA * D_MODEL ** -0.5),
    }


def reference(x, c, ctx, c_ctx, w_mod, b_mod, ln_g, ln_b, ffn1_w_in, ffn1_w_out, ffn2_w_in, ffn2_w_out,
              w_in, rg_conv_w, rg_conv_b, rg_gate_w, rg_gate_b, rg_lam, sc_conv_w, w_rg_out, w_sc_out,
              b_merge, w_o):
    xc = ctx
    batch = x.shape[0]
    zeros_state = jnp.zeros((batch, W_RG), x.dtype)
    for l in range(DEPTH):
        last = l == DEPTH - 1
        mod_lat = jnp.split((jax.nn.silu(c) @ w_mod[l] + b_mod[l])[:, None, :], N_MOD, axis=-1)
        mod_ctx = jnp.split(jax.nn.silu(c_ctx) @ w_mod[l] + b_mod[l], N_MOD, axis=-1)

        x = ffn_sublayer(x, mod_lat[0], mod_lat[1], mod_lat[2], ffn1_w_in[l], ffn1_w_out[l], ln_g[l, 0], ln_b[l, 0])
        xc = ffn_sublayer(xc, mod_ctx[0], mod_ctx[1], mod_ctx[2], ffn1_w_in[l], ffn1_w_out[l], ln_g[l, 0], ln_b[l, 0])

        hc = modulate(xc, mod_ctx[3], mod_ctx[4])
        if last:
            pc_rg = hc @ w_in[l][:, :W_RG]
        else:
            pc = hc @ w_in[l]
            pc_rg = pc[..., :W_RG]
        h_rg_c, s_f, s_b = rg_branch(pc_rg, dwconv, rg_conv_w[l], rg_conv_b[l], rg_gate_w[l], rg_gate_b[l],
                                     rg_lam[l], zeros_state, zeros_state)
        if not last:
            yc = mixer_out(pc, h_rg_c, dwconv, sc_conv_w[l], w_rg_out[l], w_sc_out[l], b_merge[l], w_o[l])
            xc = layer_norm(ALPHA * xc + mod_ctx[5] * yc, ln_g[l, 1], ln_b[l, 1])

        hl = modulate(x, mod_lat[3], mod_lat[4])
        pl = hl @ w_in[l]
        h_rg_l, _, _ = rg_branch(pl[..., :W_RG], conv_latent, rg_conv_w[l], rg_conv_b[l], rg_gate_w[l],
                                 rg_gate_b[l], rg_lam[l], s_f, s_b)
        yl = mixer_out(pl, h_rg_l, conv_latent, sc_conv_w[l], w_rg_out[l], w_sc_out[l], b_merge[l], w_o[l])
        x = layer_norm(ALPHA * x + mod_lat[5] * yl, ln_g[l, 1], ln_b[l, 1])

        x = ffn_sublayer(x, mod_lat[6], mod_lat[7], mod_lat[8], ffn2_w_in[l], ffn2_w_out[l], ln_g[l, 2], ln_b[l, 2])
        if not last:
            xc = ffn_sublayer(xc, mod_ctx[6], mod_ctx[7], mod_ctx[8], ffn2_w_in[l], ffn2_w_out[l],
                              ln_g[l, 2], ln_b[l, 2])
    return x
```

```cpp
#include <hip/hip_runtime.h>
#include <cstdio>
#include <cstdint>

namespace pg8 {
#define PG8_LAS __attribute__((address_space(3)))
typedef unsigned short bf16_t;
typedef short bf16x8 __attribute__((ext_vector_type(8)));
typedef float f32x4 __attribute__((ext_vector_type(4)));
typedef unsigned u32x4 __attribute__((ext_vector_type(4)));
constexpr int BM = 256, BK = 64, HALF = 128, HTB = HALF * BK * 2, STAGE_BYTES = 8 * HTB, NXCD = 8, WGM = 8;

__host__ __device__ __forceinline__ int lds_byte(int r, int c) { const int st = (r >> 4) * 2 + (c >> 5), rr = r & 15, cc = c & 31, ob = rr * 64 + cc * 2; return st * 1024 + (ob ^ (((ob >> 9) & 1) << 5)); }
__host__ __device__ __forceinline__ void stage_rc(int b, int& R, int& C) { const int st = b / 1024, sb = b % 1024, swz = sb ^ (((sb >> 9) & 1) << 5); R = (st >> 1) * 16 + swz / 64; C = (st & 1) * 32 + (swz % 64) / 2; }
__host__ __device__ __forceinline__ int perm32(int rho) { const int n = rho >> 4, i = rho & 15; return 8 * (i >> 2) + 4 * n + (i & 3); }

struct Unit { int pm, pn; };
struct Gemm { const bf16_t* A; const bf16_t* Bt; };

template <int NN> struct SchedX {
    int G, c, nM, sh; unsigned* flag; unsigned need; mutable int tail;
    __device__ __forceinline__ void init(int G_, int c_, int nM_, int sh_, unsigned* flag_, unsigned need_) { G = G_; c = c_; nM = nM_; sh = sh_; flag = flag_; need = need_; tail = 0; }
    __device__ __forceinline__ bool next(int i, Unit& u) const {
        const int nwg = nM * NN, nfull = (nwg / G) * G;
        int L; tail = 0;
        if (i * G < nfull) L = i * G + c;
        else { if (i * G != nfull) return false; const int k = c - sh; if (k < 0 || k >= nwg - nfull) return false; L = nfull + k; tail = 1; }
        int wgid = L; { const int q = nwg / NXCD, r = nwg % NXCD; const int xcd = wgid % NXCD, off = wgid / NXCD; wgid = (xcd < r ? xcd * (q + 1) : r * (q + 1) + (xcd - r) * q) + off; }
        constexpr int nig = WGM * NN; const int gid = wgid / nig, fm = gid * WGM, gsz = (nM - fm) < WGM ? (nM - fm) : WGM;
        u.pm = fm + ((wgid % nig) % gsz); u.pn = (wgid % nig) / gsz; return true;
    }
    __device__ __forceinline__ void a_ready(const Unit&) const {
        if (flag != nullptr && tail) { unsigned sp = 0;
            while (__hip_atomic_load(flag, __ATOMIC_RELAXED, __HIP_MEMORY_SCOPE_AGENT) < need && ++sp < (1u << 22)) __builtin_amdgcn_s_sleep(2);
            __builtin_amdgcn_fence(__ATOMIC_ACQUIRE, "agent"); }
    }
    __device__ __forceinline__ void done(const Unit&) const {}
};

template <int NN> struct Sched {
    int G, c, nM;
    __device__ __forceinline__ void init(int G_, int c_, int nM_) { G = G_; c = c_; nM = nM_; }
    __device__ __forceinline__ bool next(int i, Unit& u) const {
        const int nwg = nM * NN;
        const int L = i * G + c; if (L >= nwg) return false;
        int wgid = L; { const int q = nwg / NXCD, r = nwg % NXCD; const int xcd = wgid % NXCD, off = wgid / NXCD; wgid = (xcd < r ? xcd * (q + 1) : r * (q + 1) + (xcd - r) * q) + off; }
        constexpr int nig = WGM * NN; const int gid = wgid / nig, fm = gid * WGM, gsz = (nM - fm) < WGM ? (nM - fm) : WGM;
        u.pm = fm + ((wgid % nig) % gsz); u.pn = (wgid % nig) / gsz; return true;
    }
    __device__ __forceinline__ void a_ready(const Unit&) const {}
    __device__ __forceinline__ void done(const Unit&) const {}
};

typedef float f32x2_t __attribute__((ext_vector_type(2)));
typedef __bf16 bf16x2_t __attribute__((ext_vector_type(2)));
__device__ __forceinline__ unsigned cvt_pk_bf16(float lo, float hi) { const f32x2_t v = {lo, hi}; return __builtin_bit_cast(unsigned, __builtin_convertvector(v, bf16x2_t)); }
__device__ __forceinline__ float bflo(unsigned w) { return __uint_as_float(w << 16); }
__device__ __forceinline__ float bfhi(unsigned w) { return __uint_as_float(w & 0xffff0000u); }
__device__ __forceinline__ float sigmoidf_(float x) { return __builtin_amdgcn_rcpf(1.0f + __expf(-x)); }


struct EpiPlain {
    static constexpr bool PERM = true, AFTER_DRAIN = false;
    bf16_t* O; int ldc;
    __device__ __forceinline__ void operator()(const f32x4 (&acc)[2][2][4][2], const Unit& u, int wr, int wc, int fr, int fq) const {
        const int row0 = u.pm * BM + wr * 64 + fr, col0 = u.pn * BM + wc * 32 + 8 * fq;
#pragma unroll
        for (int ai = 0; ai < 2; ++ai)
#pragma unroll
            for (int m = 0; m < 4; ++m) { bf16_t* rowp = O + (size_t)(row0 + ai * HALF + m * 16) * ldc + col0;
#pragma unroll
                for (int bj = 0; bj < 2; ++bj) { const f32x4 v0 = acc[ai][bj][m][0], v1 = acc[ai][bj][m][1];
                    u32x4 w; w.x = cvt_pk_bf16(v0[0], v0[1]); w.y = cvt_pk_bf16(v0[2], v0[3]); w.z = cvt_pk_bf16(v1[0], v1[1]); w.w = cvt_pk_bf16(v1[2], v1[3]);
                    *(u32x4*)(rowp + bj * HALF) = w; } }
    }
};
struct EpiSwiGLU {
    static constexpr bool PERM = true, AFTER_DRAIN = false;
    bf16_t* O; int ldc;
    __device__ __forceinline__ void operator()(const f32x4 (&acc)[2][2][4][2], const Unit& u, int wr, int wc, int fr, int fq) const {
        const int row0 = u.pm * BM + wr * 64 + fr, col0 = u.pn * HALF + wc * 32 + 8 * fq;
#pragma unroll
        for (int ai = 0; ai < 2; ++ai)
#pragma unroll
            for (int m = 0; m < 4; ++m) { bf16_t* rowp = O + (size_t)(row0 + ai * HALF + m * 16) * ldc + col0;
                float o[8];
#pragma unroll
                for (int n = 0; n < 2; ++n)
#pragma unroll
                    for (int j = 0; j < 4; ++j) { const float g = acc[ai][0][m][n][j], up = acc[ai][1][m][n][j]; o[n * 4 + j] = g * sigmoidf_(g) * up; }
                u32x4 w; w.x = cvt_pk_bf16(o[0], o[1]); w.y = cvt_pk_bf16(o[2], o[3]); w.z = cvt_pk_bf16(o[4], o[5]); w.w = cvt_pk_bf16(o[6], o[7]);
                *(u32x4*)rowp = w; }
    }
};
struct EpiProj {
    static constexpr bool PERM = true, AFTER_DRAIN = false;
    bf16_t* base; size_t slot; const float* bm;
    __device__ __forceinline__ void operator()(const f32x4 (&acc)[2][2][4][2], const Unit& u, int wr, int wc, int fr, int fq) const {
        const int pn = u.pn; const int row0 = u.pm * BM + wr * 64 + fr;
        if (pn >= 24 && pn < 40) {
            bf16_t* O = base + 3 * slot; const int col0 = (pn - 24) * HALF + wc * 32 + 8 * fq;
#pragma unroll
            for (int ai = 0; ai < 2; ++ai)
#pragma unroll
                for (int m = 0; m < 4; ++m) { bf16_t* rowp = O + (size_t)(row0 + ai * HALF + m * 16) * 2048 + col0;
                    const f32x4 p0 = acc[ai][0][m][0] * acc[ai][1][m][0], p1 = acc[ai][0][m][1] * acc[ai][1][m][1];
                    u32x4 w; w.x = cvt_pk_bf16(p0[0], p0[1]); w.y = cvt_pk_bf16(p0[2], p0[3]); w.z = cvt_pk_bf16(p1[0], p1[1]); w.w = cvt_pk_bf16(p1[2], p1[3]);
                    *(u32x4*)rowp = w; }
        } else {
            int sec, tl; if (pn < 24) { sec = pn >> 3; tl = pn & 7; } else { sec = 4 + ((pn - 40) >> 3); tl = (pn - 40) & 7; }
            bf16_t* O = base + (size_t)sec * slot; const int col0 = tl * BM + wc * 32 + 8 * fq;
            if (sec == 0 || sec == 2) {
#pragma unroll
                for (int ai = 0; ai < 2; ++ai)
#pragma unroll
                    for (int m = 0; m < 4; ++m) { bf16_t* rowp = O + (size_t)(row0 + ai * HALF + m * 16) * 2048 + col0;
#pragma unroll
                        for (int bj = 0; bj < 2; ++bj) { const f32x4 v0 = acc[ai][bj][m][0], v1 = acc[ai][bj][m][1];
                            u32x4 w; w.x = cvt_pk_bf16(v0[0], v0[1]); w.y = cvt_pk_bf16(v0[2], v0[3]); w.z = cvt_pk_bf16(v1[0], v1[1]); w.w = cvt_pk_bf16(v1[2], v1[3]);
                            *(u32x4*)(rowp + bj * HALF) = w; } }
            } else if (sec == 1) {
#pragma unroll
                for (int ai = 0; ai < 2; ++ai)
#pragma unroll
                    for (int m = 0; m < 4; ++m) { bf16_t* rowp = O + (size_t)(row0 + ai * HALF + m * 16) * 2048 + col0;
#pragma unroll
                        for (int bj = 0; bj < 2; ++bj) { float o[8];
#pragma unroll
                            for (int n = 0; n < 2; ++n)
#pragma unroll
                                for (int j = 0; j < 4; ++j) { const float x = acc[ai][bj][m][n][j]; o[n * 4 + j] = x * sigmoidf_(1.5957691216f * (x + 0.044715f * x * x * x)); }
                            u32x4 w; w.x = cvt_pk_bf16(o[0], o[1]); w.y = cvt_pk_bf16(o[2], o[3]); w.z = cvt_pk_bf16(o[4], o[5]); w.w = cvt_pk_bf16(o[6], o[7]);
                            *(u32x4*)(rowp + bj * HALF) = w; } }
            } else {
                const float* bb = bm + (sec - 4) * 2048 + col0;
                f32x4 bv[2][2];
#pragma unroll
                for (int bj = 0; bj < 2; ++bj)
#pragma unroll
                    for (int n = 0; n < 2; ++n) bv[bj][n] = *(const f32x4*)(bb + bj * HALF + 4 * n);
#pragma unroll
                for (int ai = 0; ai < 2; ++ai)
#pragma unroll
                    for (int m = 0; m < 4; ++m) { bf16_t* rowp = O + (size_t)(row0 + ai * HALF + m * 16) * 2048 + col0;
#pragma unroll
                        for (int bj = 0; bj < 2; ++bj) { float o[8];
#pragma unroll
                            for (int n = 0; n < 2; ++n)
#pragma unroll
                                for (int j = 0; j < 4; ++j) o[n * 4 + j] = sigmoidf_(acc[ai][bj][m][n][j] + bv[bj][n][j]);
                            u32x4 w; w.x = cvt_pk_bf16(o[0], o[1]); w.y = cvt_pk_bf16(o[2], o[3]); w.z = cvt_pk_bf16(o[4], o[5]); w.w = cvt_pk_bf16(o[6], o[7]);
                            *(u32x4*)(rowp + bj * HALF) = w; } }
            }
        }
    }
};
struct EpiGate {
    static constexpr bool PERM = true, AFTER_DRAIN = false;
    const bf16_t* XC; bf16_t* LA0; bf16_t* V0; bf16_t* LA1; bf16_t* V1;
    const float* gb;
    const float* ls8t;
    __device__ __forceinline__ void operator()(const f32x4 (&acc)[2][2][4][2], const Unit& u, int wr, int wc, int fr, int fq) const {
        const int pn = u.pn, hd = pn >> 1, d = pn & 1;
        const int row0 = u.pm * BM + wr * 64 + fr, ch0 = hd * HALF + wc * 32 + 8 * fq;
        bf16_t* LA = d ? LA1 : LA0; bf16_t* V = d ? V1 : V0;
        const float* pbr = gb + (size_t)(d * 2 + 0) * 2048 + ch0; const float* pbi = gb + (size_t)(d * 2 + 1) * 2048 + ch0; const float* pls = ls8t + (size_t)d * 2048 + ch0;
        f32x4 br[2], bi[2], ls8[2];
#pragma unroll
        for (int n = 0; n < 2; ++n) { br[n] = *(const f32x4*)(pbr + 4 * n); bi[n] = *(const f32x4*)(pbi + 4 * n); ls8[n] = *(const f32x4*)(pls + 4 * n); }
#pragma unroll
        for (int ai = 0; ai < 2; ++ai) {
#pragma unroll
          for (int mh = 0; mh < 4; mh += 2) {
            u32x4 xw[4];
#pragma unroll
            for (int m = mh; m < mh + 2; ++m) xw[m] = *(const u32x4*)(XC + (size_t)(row0 + ai * HALF + m * 16) * 2048 + ch0);
#pragma unroll
            for (int m = mh; m < mh + 2; ++m) { const size_t off = (size_t)(row0 + ai * HALF + m * 16) * 2048 + ch0;
                const float uu[8] = {bflo(xw[m].x), bfhi(xw[m].x), bflo(xw[m].y), bfhi(xw[m].y), bflo(xw[m].z), bfhi(xw[m].z), bflo(xw[m].w), bfhi(xw[m].w)};
                float la[8], vv[8];
#pragma unroll
                for (int n = 0; n < 2; ++n)
#pragma unroll
                    for (int j = 0; j < 4; ++j) { const int k = n * 4 + j;
                        const float r = sigmoidf_(acc[ai][0][m][n][j] + br[n][j]), ig = sigmoidf_(acc[ai][1][m][n][j] + bi[n][j]);
                        const float l1 = ls8[n][j] * r, z = 2.0f * l1;
                        const float em = z > -0.02f ? -z * (1.0f + z * (0.5f + z * (0.16666667f + z * 0.041666667f))) : 1.0f - __expf(z);
                        la[k] = l1; vv[k] = __builtin_sqrtf(em) * ig * uu[k]; }
                u32x4 w; w.x = cvt_pk_bf16(la[0], la[1]); w.y = cvt_pk_bf16(la[2], la[3]); w.z = cvt_pk_bf16(la[4], la[5]); w.w = cvt_pk_bf16(la[6], la[7]);
                *(u32x4*)(LA + off) = w;
                w.x = cvt_pk_bf16(vv[0], vv[1]); w.y = cvt_pk_bf16(vv[2], vv[3]); w.z = cvt_pk_bf16(vv[4], vv[5]); w.w = cvt_pk_bf16(vv[6], vv[7]);
                *(u32x4*)(V + off) = w; }
            asm volatile("" ::: "memory"); } }
    }
};
template <bool ADD> struct EpiGated {
    static constexpr bool PERM = true, AFTER_DRAIN = false;
    bf16_t* O; const bf16_t* G; const bf16_t* T; const float* TP; int ctx0;
    __device__ __forceinline__ void operator()(const f32x4 (&acc)[2][2][4][2], const Unit& u, int wr, int wc, int fr, int fq) const {
        const int row0 = u.pm * BM + wr * 64 + fr, col0 = u.pn * BM + wc * 32 + 8 * fq;
        const bool part = ADD && TP != nullptr && u.pm * BM >= ctx0;
        const __amdgpu_buffer_rsrc_t rTP = __builtin_amdgcn_make_buffer_rsrc((void*)TP, 0, 4 * 1024 * 2048 * 4, 0x00020000);
        const int vo = ((row0 - ctx0) * 2048 + col0) * 4;
#pragma unroll
        for (int ai = 0; ai < 2; ++ai) {
            u32x4 gwv[4][2], twv[4][2];
#pragma unroll
            for (int m = 0; m < 4; ++m)
#pragma unroll
                for (int bj = 0; bj < 2; ++bj) { const size_t off = (size_t)(row0 + ai * HALF + m * 16) * 2048 + col0;
                    gwv[m][bj] = *(const u32x4*)(G + off + bj * HALF);
                    if (ADD && !part) twv[m][bj] = *(const u32x4*)(T + off + bj * HALF); }
#pragma unroll
            for (int m = 0; m < 4; ++m) { const size_t off = (size_t)(row0 + ai * HALF + m * 16) * 2048 + col0;
#pragma unroll
                for (int bj = 0; bj < 2; ++bj) { const u32x4 gw = gwv[m][bj];
                    float o[8] = {bflo(gw.x) * acc[ai][bj][m][0][0], bfhi(gw.x) * acc[ai][bj][m][0][1], bflo(gw.y) * acc[ai][bj][m][0][2], bfhi(gw.y) * acc[ai][bj][m][0][3],
                                  bflo(gw.z) * acc[ai][bj][m][1][0], bfhi(gw.z) * acc[ai][bj][m][1][1], bflo(gw.w) * acc[ai][bj][m][1][2], bfhi(gw.w) * acc[ai][bj][m][1][3]};
                    if (ADD) {
                        if (part) {
#pragma unroll
                            for (int ks = 0; ks < 4; ++ks) { const int so = (ks * 1024 * 2048 + (ai * HALF + m * 16) * 2048 + bj * HALF) * 4;
                                const f32x4 a = __builtin_bit_cast(f32x4, __builtin_amdgcn_raw_buffer_load_b128(rTP, vo, so, 0)), b = __builtin_bit_cast(f32x4, __builtin_amdgcn_raw_buffer_load_b128(rTP, vo, so + 16, 0));
                                o[0] += a[0]; o[1] += a[1]; o[2] += a[2]; o[3] += a[3]; o[4] += b[0]; o[5] += b[1]; o[6] += b[2]; o[7] += b[3]; } }
                        else { const u32x4 tw = twv[m][bj];
                            o[0] += bflo(tw.x); o[1] += bfhi(tw.x); o[2] += bflo(tw.y); o[3] += bfhi(tw.y); o[4] += bflo(tw.z); o[5] += bfhi(tw.z); o[6] += bflo(tw.w); o[7] += bfhi(tw.w); } }
                    u32x4 w; w.x = cvt_pk_bf16(o[0], o[1]); w.y = cvt_pk_bf16(o[2], o[3]); w.z = cvt_pk_bf16(o[4], o[5]); w.w = cvt_pk_bf16(o[6], o[7]);
                    *(u32x4*)(O + off + bj * HALF) = w; } }
        }
    }
};
template <bool HASG> struct EpiPartial {
    static constexpr bool PERM = true, AFTER_DRAIN = false;
    float* P; const bf16_t* G;
    int grow0;
    __device__ __forceinline__ void operator()(const f32x4 (&acc)[2][2][4][2], const Unit& u, int wr, int wc, int fr, int fq) const {
        const int ks = u.pn >> 3, ct = u.pn & 7;
        const int row0 = u.pm * BM + wr * 64 + fr, col0 = ct * BM + wc * 32 + 8 * fq;
        const __amdgpu_buffer_rsrc_t rP = __builtin_amdgcn_make_buffer_rsrc((void*)(P + (size_t)ks * 1024 * 2048), 0, 1024 * 2048 * 4, 0x00020000);
        const __amdgpu_buffer_rsrc_t rG = __builtin_amdgcn_make_buffer_rsrc((void*)(HASG ? G + (size_t)grow0 * 2048 : (const bf16_t*)P), 0, 1024 * 2048 * 2, 0x00020000);
        const int vo = (row0 * 2048 + col0) * 4, vg = (row0 * 2048 + col0) * 2;
#pragma unroll
        for (int ai = 0; ai < 2; ++ai)
#pragma unroll
            for (int m = 0; m < 4; ++m)
#pragma unroll
                for (int bj = 0; bj < 2; ++bj) { f32x4 v0 = acc[ai][bj][m][0], v1 = acc[ai][bj][m][1]; const int so = ((ai * HALF + m * 16) * 2048 + bj * HALF);
                    if constexpr (HASG) { const u32x4 gw = __builtin_amdgcn_raw_buffer_load_b128(rG, vg, so * 2, 0);
                        v0 = v0 * (f32x4){bflo(gw.x), bfhi(gw.x), bflo(gw.y), bfhi(gw.y)}; v1 = v1 * (f32x4){bflo(gw.z), bfhi(gw.z), bflo(gw.w), bfhi(gw.w)}; }
                    __builtin_amdgcn_raw_buffer_store_b128(__builtin_bit_cast(u32x4, v0), rP, vo, so * 4, 0); __builtin_amdgcn_raw_buffer_store_b128(__builtin_bit_cast(u32x4, v1), rP, vo, so * 4 + 16, 0); }
    }
};

template <class Epi, bool ALIGN_EPI, int LDA, int LDB, int KD, int KDIV, int KSTR, int BMOD, class SchedT>
__device__ __forceinline__ void gemm_phase(PG8_LAS unsigned char* lds, const Gemm g, const SchedT& S, const Epi& E, const int tid) {
    const int wid = __builtin_amdgcn_readfirstlane(tid >> 6), lane = tid & 63, wr = wid >> 2, wc = wid & 3, fr = lane & 15, fq = lane >> 4;
    constexpr int nt = KD / BK;
    unsigned voffA[2], voffB[2];
#pragma unroll
    for (int i = 0; i < 2; ++i) { int R, C; stage_rc(tid * 16 + i * 8192, R, C); const int Rb = Epi::PERM ? ((R & ~31) + perm32(R & 31)) : R;
        voffA[i] = (unsigned)(R * LDA + C) * 2u; voffB[i] = (unsigned)(Rb * LDB + C) * 2u; }
    constexpr size_t kstep = (size_t)(BK * 2);
    constexpr size_t hstepA = (size_t)HALF * LDA * 2, hstepB = (size_t)HALF * LDB * 2;
    const unsigned ldsw = (unsigned)wid * 1024u;
    const int aoff = lds_byte(wr * 64 + fr, fq * 8), boff = lds_byte(wc * 32 + fr, fq * 8);
#define PG8_SA(b, h) (((b) * 2 + (h)) * HTB)
#define PG8_SB(b, h) ((4 + (b) * 2 + (h)) * HTB)
#define PG8_STAGE(bufoff, gbase, voff) do { _Pragma("unroll") for (int _i = 0; _i < 2; ++_i) \
        __builtin_amdgcn_global_load_lds((const unsigned*)((const char*)(gbase) + (voff)[_i]), (PG8_LAS unsigned*)(lds + (bufoff) + ldsw + _i * 8192), 16, 0, 0); } while (0)
#define PG8_LDA(dst, b, h) do { _Pragma("unroll") for (int m = 0; m < 4; ++m) _Pragma("unroll") for (int k = 0; k < 2; ++k) dst[m][k] = *(const PG8_LAS bf16x8*)(lds + PG8_SA(b, h) + aoff + m * 2048 + k * 1024); } while (0)
#define PG8_LDB(dst, b, h) do { _Pragma("unroll") for (int n = 0; n < 2; ++n) _Pragma("unroll") for (int k = 0; k < 2; ++k) dst[n][k] = *(const PG8_LAS bf16x8*)(lds + PG8_SB(b, h) + boff + n * 2048 + k * 1024); } while (0)
#define PG8_MMA(ai, bj, At, Bt) do { __builtin_amdgcn_s_setprio(1); _Pragma("unroll") for (int m = 0; m < 4; ++m) _Pragma("unroll") for (int n = 0; n < 2; ++n) _Pragma("unroll") for (int k = 0; k < 2; ++k) \
        acc[ai][bj][m][n] = __builtin_amdgcn_mfma_f32_16x16x32_bf16(Bt[n][k], At[m][k], acc[ai][bj][m][n], 0, 0, 0); __builtin_amdgcn_s_setprio(0); } while (0)
#define PG8_WAIT_V(n) asm volatile("s_waitcnt vmcnt(" #n ")" ::: "memory")
#define PG8_WAIT_L(n) asm volatile("s_waitcnt lgkmcnt(" #n ")" ::: "memory")
#define PG8_BAR __builtin_amdgcn_s_barrier()
#define PG8_SCHED __builtin_amdgcn_sched_barrier(0)
#define PG8_APTR(u) ((const char*)g.A + ((size_t)(u).pm * BM * LDA + (size_t)(KDIV ? ((u).pn / (KDIV ? KDIV : 1)) * KSTR : 0)) * 2)
#define PG8_BPTR(u) ((const char*)g.Bt + ((size_t)(BMOD ? (u).pn % (BMOD ? BMOD : 1) : (u).pn) * BM * LDB + (size_t)(BMOD ? ((u).pn / (BMOD ? BMOD : 1)) * KSTR : 0)) * 2)
    Unit cur, nxt; int ui = 0;
    if (!S.next(0, cur)) return;
    f32x4 acc[2][2][4][2];
#pragma unroll
    for (int a = 0; a < 2; ++a)
#pragma unroll
        for (int b = 0; b < 2; ++b)
#pragma unroll
            for (int m = 0; m < 4; ++m)
#pragma unroll
                for (int n = 0; n < 2; ++n) acc[a][b][m][n] = (f32x4){0.f, 0.f, 0.f, 0.f};
    bf16x8 At[4][2], B0[2][2], B1[2][2];
    const char* cA = PG8_APTR(cur); const char* cB = PG8_BPTR(cur);
    S.a_ready(cur);
    PG8_STAGE(PG8_SB(0, 0), cB, voffB); PG8_STAGE(PG8_SB(0, 1), cB + hstepB, voffB); PG8_STAGE(PG8_SA(0, 0), cA, voffA); PG8_STAGE(PG8_SA(0, 1), cA + hstepA, voffA);
    if (wr == 1) PG8_BAR;
    PG8_WAIT_V(2); PG8_BAR;
    PG8_STAGE(PG8_SB(1, 0), cB + kstep, voffB); PG8_STAGE(PG8_SA(1, 0), cA + kstep, voffA); PG8_STAGE(PG8_SB(1, 1), cB + hstepB + kstep, voffB);
    PG8_WAIT_V(6); PG8_BAR;
    for (;;) {
        const bool has_next = S.next(ui + 1, nxt);
        const char* nA = has_next ? PG8_APTR(nxt) : cA; const char* nB = has_next ? PG8_BPTR(nxt) : cB;
        for (int t = 0; t < nt; t += 2) {
            const bool last = (t == nt - 2);
            const char* a1 = cA + (size_t)(t + 1) * kstep;
            const char* a2 = last ? nA : cA + (size_t)(t + 2) * kstep; const char* b2 = last ? nB : cB + (size_t)(t + 2) * kstep;
            const char* a3 = a2 + kstep; const char* b3 = b2 + kstep;
            if (last && has_next) S.a_ready(nxt);
            PG8_LDB(B0, 0, 0); PG8_LDB(B1, 0, 1); PG8_SCHED; PG8_LDA(At, 0, 0); PG8_STAGE(PG8_SA(1, 1), a1 + hstepA, voffA);
            PG8_WAIT_V(8); PG8_WAIT_L(0); PG8_BAR; PG8_MMA(0, 0, At, B0); PG8_MMA(0, 1, At, B1); PG8_BAR; PG8_SCHED;
            PG8_LDA(At, 0, 1); PG8_STAGE(PG8_SB(0, 0), b2, voffB); PG8_STAGE(PG8_SB(0, 1), b2 + hstepB, voffB); PG8_STAGE(PG8_SA(0, 0), a2, voffA);
            PG8_WAIT_V(8); PG8_WAIT_L(0); PG8_BAR; PG8_MMA(1, 0, At, B0); PG8_MMA(1, 1, At, B1); PG8_BAR; PG8_SCHED;
            PG8_LDB(B0, 1, 0); PG8_LDB(B1, 1, 1); PG8_SCHED; PG8_LDA(At, 1, 0); PG8_STAGE(PG8_SA(0, 1), a2 + hstepA, voffA);
            PG8_WAIT_V(8); PG8_WAIT_L(0); PG8_BAR; PG8_MMA(0, 0, At, B0); PG8_MMA(0, 1, At, B1); PG8_BAR; PG8_SCHED;
            PG8_LDA(At, 1, 1); PG8_STAGE(PG8_SB(1, 0), b3, voffB); PG8_STAGE(PG8_SB(1, 1), b3 + hstepB, voffB); PG8_STAGE(PG8_SA(1, 0), a3, voffA);
            PG8_WAIT_V(8); PG8_WAIT_L(0); PG8_BAR; PG8_MMA(1, 0, At, B0); PG8_MMA(1, 1, At, B1); PG8_BAR; PG8_SCHED;
        }
        if constexpr (ALIGN_EPI) { if (wr == 0) PG8_BAR; }
        E(acc, cur, wr, wc, fr, fq); S.done(cur);
        if (!has_next) break;
#pragma unroll
        for (int a = 0; a < 2; ++a)
#pragma unroll
            for (int b = 0; b < 2; ++b)
#pragma unroll
                for (int m = 0; m < 4; ++m)
#pragma unroll
                    for (int n = 0; n < 2; ++n) acc[a][b][m][n] = (f32x4){0.f, 0.f, 0.f, 0.f};
        cur = nxt; cA = nA; cB = nB; ++ui;
        if constexpr (ALIGN_EPI) { if (wr == 1) PG8_BAR; }
    }
    PG8_WAIT_V(0);
    if constexpr (!ALIGN_EPI) { if (wr == 0) PG8_BAR; }
    PG8_BAR;
#undef PG8_SA
#undef PG8_SB
#undef PG8_STAGE
#undef PG8_LDA
#undef PG8_LDB
#undef PG8_MMA
#undef PG8_WAIT_V
#undef PG8_WAIT_L
#undef PG8_BAR
#undef PG8_SCHED
#undef PG8_APTR
#undef PG8_BPTR
}
}

constexpr int NWAVES = 8;
constexpr int D = 2048, BATCH = 4, SEQ = 4096, CTXL = 256, DFF = 5632, DEPTH = 2;
constexpr int ML = BATCH * SEQ, MC = BATCH * CTXL, M = ML + MC, NPAN = M / 256;
constexpr int PROJ_W = 14336, NMODC = 9 * D;
constexpr float LN_EPS = 1e-5f, ALPHA = 1.41421356237f;
static_assert(M % 256 == 0 && NPAN == 68, "row panels");

constexpr size_t MiB = 1u << 20;
constexpr size_t WS_CTL = 0, CTL_ZERO_BYTES = 32 * 1024;
constexpr size_t WS_MODP = 1 * MiB;
constexpr size_t WS_MOD = 7 * MiB;
constexpr size_t WS_AGG = 8 * MiB;
constexpr size_t WS_LS8 = 8 * MiB + 2560 * 1024;
constexpr size_t WS_XCTX = 11 * MiB;
constexpr size_t WS_W = 20 * MiB;
constexpr size_t W_1IN = WS_W, W_1OUT = W_1IN + 44 * MiB, W_2IN = W_1OUT + 22 * MiB, W_2OUT = W_2IN + 44 * MiB, W_IN = W_2OUT + 22 * MiB,
                 W_RG = W_IN + 56 * MiB, W_SC = W_RG + 8 * MiB, W_O = W_SC + 8 * MiB, W_G2 = W_O + 8 * MiB, W_END = W_G2 + 4 * MiB;
constexpr size_t SLOT = 68 * MiB;
constexpr size_t SLOT_ELEMS = SLOT / 2;
constexpr size_t WS_H = 236 * MiB, WS_Y = WS_H + SLOT, WS_S0 = WS_Y + SLOT, W_2OUT_ALT = WS_S0 + 10 * SLOT, WS_XHI = W_2OUT_ALT + 22 * MiB, WS_XLO = WS_XHI + 68 * MiB, WS_END = WS_XLO + 34 * MiB;
static_assert(W_END <= WS_H && (size_t)M * D * 2 == SLOT && (size_t)M * DFF * 2 <= 3 * SLOT, "d_ws map");
constexpr int CW_BAR = 4096;

constexpr int RING_OFF = 0, RING_BYTES = 131072;
constexpr int LDS_BYTES = 147456;
constexpr int LDSCTL_OFF = LDS_BYTES - 1024, MISC_OFF = LDSCTL_OFF + 320;

#define GAS __attribute__((address_space(1)))
#define LAS __attribute__((address_space(3)))
typedef unsigned short bf16;
typedef unsigned v4u __attribute__((ext_vector_type(4)));
typedef unsigned v2u __attribute__((ext_vector_type(2)));
typedef float f32x4 __attribute__((ext_vector_type(4)));
#define LDS_WAIT() asm volatile("s_waitcnt lgkmcnt(0)" ::: "memory")
using pg8::cvt_pk_bf16; using pg8::bflo; using pg8::bfhi;

#define XB_TMO      128
#define XB_XCNT(j)  (256  + 64 * (j))
#define XB_XSUB(j)  (1280 + 64 * (j))
#define XB_XGEN(j)  (2304 + 64 * (j))
#define XB_TOP      3328
#define XB_TOPGEN   3392
#define XCD_BAR_WORDS 3456
#define XB_SPIN_CAP (1u << 18)
__device__ __forceinline__ unsigned xb_ld(unsigned* p)              { return __hip_atomic_load(p, __ATOMIC_RELAXED, __HIP_MEMORY_SCOPE_AGENT); }
__device__ __forceinline__ unsigned xb_add(unsigned* p, unsigned v) { return __hip_atomic_fetch_add(p, v, __ATOMIC_RELAXED, __HIP_MEMORY_SCOPE_AGENT); }
__device__ __forceinline__ unsigned xb_xcc_id() { return (unsigned)__builtin_amdgcn_s_getreg((3 << 11) | 20) & 0xFu; }
#define XB_SPIN(cond, bar) do { unsigned _sp = 0; while (cond) { __builtin_amdgcn_s_sleep(1); \
    if ((++_sp & 255u) == 0u) { if (xb_ld(&(bar)[XB_TMO])) break; if (_sp > XB_SPIN_CAP) { atomicAdd(&(bar)[XB_TMO], 1u); break; } } } } while (0)
struct XcdBarrier { unsigned* bar; unsigned x; volatile LAS unsigned* st; unsigned G; };
__device__ __forceinline__ XcdBarrier xcd_barrier_post(unsigned* bar, volatile LAS unsigned* st) {
    XcdBarrier b; b.bar = bar; b.x = xb_xcc_id(); b.st = st; b.G = 0u;
    if (threadIdx.x == 0) (void)xb_add(&bar[XB_XCNT(b.x)], 1u);
    return b;
}
__device__ __forceinline__ void xcd_barrier_complete(unsigned* bar, unsigned x, unsigned& nloc, unsigned& nx, const unsigned G) {
    unsigned sum, cnt, mine, sp = 0u;
    for (;;) {
        sum = 0u; cnt = 0u; mine = 0u;
#pragma unroll
        for (unsigned j = 0; j < 16; ++j) { const unsigned c = xb_ld(&bar[XB_XCNT(j)]); sum += c; cnt += (c > 0u) ? 1u : 0u; mine = (j == x) ? c : mine; }
        if (sum == G) break;
        __builtin_amdgcn_s_sleep(1);
        if ((++sp & 255u) == 0u) { if (xb_ld(&bar[XB_TMO])) break; if (sp > XB_SPIN_CAP) { atomicAdd(&bar[XB_TMO], 1u); break; } }
    }
    nloc = mine > 0u ? mine : 1u; nx = cnt > 0u ? cnt : 1u;
}
__device__ __forceinline__ void xcd_barrier(const XcdBarrier& b, const bool is_t0) {
    asm volatile("s_waitcnt vmcnt(0)" ::: "memory");
    __syncthreads();
    if (is_t0) {
        unsigned* bar = b.bar;
        __builtin_amdgcn_s_waitcnt(0);
        unsigned nloc = b.st[0], nx = b.st[1];
        if (nloc == 0u) { xcd_barrier_complete(bar, b.x, nloc, nx, b.G); b.st[0] = nloc; b.st[1] = nx; }
        const unsigned old = xb_add(&bar[XB_XSUB(b.x)], 1u);
        const unsigned gen = old / nloc;
        if (old + 1u == (gen + 1u) * nloc) {
            __builtin_amdgcn_fence(__ATOMIC_RELEASE, "agent");
            asm volatile("s_waitcnt vmcnt(0)" ::: "memory");
            const unsigned og = xb_add(&bar[XB_TOP], 1u);
            const unsigned tg = og / nx;
            if (og + 1u == (tg + 1u) * nx) xb_add(&bar[XB_TOPGEN], 1u);
            else XB_SPIN(xb_ld(&bar[XB_TOPGEN]) == tg, bar);
            __builtin_amdgcn_fence(__ATOMIC_ACQUIRE, "agent");
            xb_add(&bar[XB_XGEN(b.x)], 1u);
            asm volatile("s_waitcnt vmcnt(0)" ::: "memory");
        } else {
            XB_SPIN(xb_ld(&bar[XB_XGEN(b.x)]) == gen, bar);
            __builtin_amdgcn_fence(__ATOMIC_ACQUIRE, "agent");
            asm volatile("s_waitcnt vmcnt(0)" ::: "memory");
        }
    }
    __syncthreads();
}

__device__ __forceinline__ float wave_sum(float v, int lane) {
#pragma unroll
    for (int o = 1; o < 64; o <<= 1) v += __builtin_bit_cast(float, __builtin_amdgcn_ds_bpermute((lane ^ o) << 2, __builtin_bit_cast(int, v)));
    return v;
}
__device__ __forceinline__ void transpose_item(const float* __restrict__ W, int N, int k0, int n0, bf16* dst, int ldd, LAS float* scr, int lane) {
    float wv[32];
#pragma unroll
    for (int i = 0; i < 32; ++i) { const int kk = 2 * i + (lane >> 5); wv[i] = W[(size_t)(k0 + kk) * N + n0 + (lane & 31)]; }
#pragma unroll
    for (int i = 0; i < 32; ++i) { const int kk = 2 * i + (lane >> 5); scr[kk * 33 + (lane & 31)] = wv[i]; }
    LDS_WAIT(); asm volatile("" ::: "memory");
    const int c = lane & 7;
#pragma unroll
    for (int j = 0; j < 4; ++j) { const int n = (lane >> 3) + 8 * j; const LAS float* s = scr + (8 * c) * 33 + n;
        v4u o; o.x = cvt_pk_bf16(s[0 * 33], s[1 * 33]); o.y = cvt_pk_bf16(s[2 * 33], s[3 * 33]); o.z = cvt_pk_bf16(s[4 * 33], s[5 * 33]); o.w = cvt_pk_bf16(s[6 * 33], s[7 * 33]);
        *(GAS v4u*)(dst + (size_t)n * ldd + 8 * c) = o; }
    LDS_WAIT(); asm volatile("" ::: "memory");
}
__device__ __forceinline__ int map_ffn_in(int n) { return n < DFF ? (n >> 7) * 256 + (n & 127) : ((n - DFF) >> 7) * 256 + 128 + ((n - DFF) & 127); }
__device__ __forceinline__ int map_proj(int n) {
    if (n < 6144 || n >= 10240) return n;
    if (n < 8192) return 6144 + ((n - 6144) >> 7) * 256 + ((n - 6144) & 127);
    return 6144 + ((n - 8192) >> 7) * 256 + 128 + ((n - 8192) & 127);
}

struct Args { const float* in[23]; float* out; unsigned char* ws; int grid; int pad; };
enum { I_X = 0, I_C, I_CTX, I_CCTX, I_WMOD, I_BMOD, I_LNG, I_LNB, I_F1IN, I_F1OUT, I_F2IN, I_F2OUT, I_WIN, I_RGCW, I_RGCB, I_RGGW, I_RGGB, I_RGLAM, I_SCCW, I_WRGO, I_WSCO, I_BMERGE, I_WO };

constexpr int CV_IN = (D / 64) * (2 * DFF / 32), CV_OUT = (DFF / 64) * (D / 32), CV_PR = (D / 64) * (PROJ_W / 32), CV_SQ = (D / 64) * (D / 32), CV_GT = 64 * 8;
constexpr int CV_UP = (CV_IN * 3) / 4;
constexpr int CV_FIRST = CV_IN + CV_OUT;
constexpr int CV_ALL = 2 * CV_IN + 2 * CV_OUT + CV_PR + 3 * CV_SQ + CV_GT;
__device__ __forceinline__ void convert_weights(const Args& a, int l, int lo, int hi, int alt2, unsigned char* ws, LAS unsigned char* lds, int wi, int NW, int wave, int lane) {
    LAS float* scr = (LAS float*)(lds + wave * 8448);
    for (int it = lo + wi; it < hi; it += NW) {
        int r = it;
        if (r < CV_IN) { const int nblk = 2 * DFF / 32, kb = r / nblk, nb = r % nblk;
            transpose_item(a.in[I_F1IN] + (size_t)l * D * 2 * DFF, 2 * DFF, kb * 64, nb * 32, (bf16*)(ws + W_1IN) + (size_t)map_ffn_in(nb * 32) * D + kb * 64, D, scr, lane); continue; }
        r -= CV_IN;
        if (r < CV_OUT) { const int nblk = D / 32, kb = r / nblk, nb = r % nblk;
            transpose_item(a.in[I_F1OUT] + (size_t)l * DFF * D, D, kb * 64, nb * 32, (bf16*)(ws + W_1OUT) + (size_t)(nb * 32) * DFF + kb * 64, DFF, scr, lane); continue; }
        r -= CV_OUT;
        if (r < CV_IN) { const int nblk = 2 * DFF / 32, kb = r / nblk, nb = r % nblk;
            transpose_item(a.in[I_F2IN] + (size_t)l * D * 2 * DFF, 2 * DFF, kb * 64, nb * 32, (bf16*)(ws + W_2IN) + (size_t)map_ffn_in(nb * 32) * D + kb * 64, D, scr, lane); continue; }
        r -= CV_IN;
        if (r < CV_OUT) { const int nblk = D / 32, kb = r / nblk, nb = r % nblk;
            transpose_item(a.in[I_F2OUT] + (size_t)l * DFF * D, D, kb * 64, nb * 32, (bf16*)(ws + (alt2 ? W_2OUT_ALT : W_2OUT)) + (size_t)(nb * 32) * DFF + kb * 64, DFF, scr, lane); continue; }
        r -= CV_OUT;
        if (r < CV_PR) { const int nblk = PROJ_W / 32, kb = r / nblk, nb = r % nblk;
            transpose_item(a.in[I_WIN] + (size_t)l * D * PROJ_W, PROJ_W, kb * 64, nb * 32, (bf16*)(ws + W_IN) + (size_t)map_proj(nb * 32) * D + kb * 64, D, scr, lane); continue; }
        r -= CV_PR;
        if (r < 3 * CV_SQ) { const int w = r / CV_SQ; r -= w * CV_SQ; const int nblk = D / 32, kb = r / nblk, nb = r % nblk;
            const float* W = (w == 0 ? a.in[I_WRGO] : (w == 1 ? a.in[I_WSCO] : a.in[I_WO])) + (size_t)l * D * D; bf16* WT = (bf16*)(ws + (w == 0 ? W_RG : (w == 1 ? W_SC : W_O)));
            transpose_item(W, D, kb * 64, nb * 32, WT + (size_t)(nb * 32) * D + kb * 64, D, scr, lane); continue; }
        r -= 3 * CV_SQ;
        {
            const int blk = r >> 3, sub = r & 7, kb = sub >> 2, nb = sub & 3, h = blk & 15, g = (blk >> 4) & 1, d = blk >> 5;
            const float* W = a.in[I_RGGW] + ((size_t)l * 64 + blk) * 16384; bf16* WT = (bf16*)(ws + W_G2);
            const int tn = h * 2 + d;
            transpose_item(W, 128, kb * 64, nb * 32, WT + (size_t)(tn * 256 + g * 128 + nb * 32) * 128 + kb * 64, 128, scr, lane); }
    }
}

template <bool IN3, bool OUT3>
__device__ __forceinline__ void ln_phase(const float* xin_lat, const float* xin_ctx, float* xout_lat, float* xout_ctx, unsigned short* XH, unsigned char* XL, const bf16* Y, const float* gate, float s,
                                         const float* lng, const float* lnb, const float* nsh, const float* nsc, bf16* H, int gw, int NGW, int lane, int nrows, const float* part) {
    if (part) {
        const __amdgpu_buffer_rsrc_t rPT = __builtin_amdgcn_make_buffer_rsrc((void*)part, 0, 4 * MC * D * 4, 0x00020000);
        for (int row = ML + gw; row < nrows; row += NGW) { const int vo = ((row - ML) * D + 4 * lane) * 4;
#pragma unroll
            for (int j = 0; j < 8; ++j) {
                const f32x4 y = (__builtin_bit_cast(f32x4, __builtin_amdgcn_raw_buffer_load_b128(rPT, vo, (256 * j) * 4, 0)) + __builtin_bit_cast(f32x4, __builtin_amdgcn_raw_buffer_load_b128(rPT, vo, (MC * D + 256 * j) * 4, 0)))
                              + (__builtin_bit_cast(f32x4, __builtin_amdgcn_raw_buffer_load_b128(rPT, vo, (2 * MC * D + 256 * j) * 4, 0)) + __builtin_bit_cast(f32x4, __builtin_amdgcn_raw_buffer_load_b128(rPT, vo, (3 * MC * D + 256 * j) * 4, 0)));
                v2u w; w.x = cvt_pk_bf16(y[0], y[1]); w.y = cvt_pk_bf16(y[2], y[3]); *(GAS v2u*)((bf16*)Y + (size_t)row * D + 4 * lane + 256 * j) = w; } }
        asm volatile("s_waitcnt vmcnt(0)" ::: "memory");
    }
#define LN_C(j) (8 * lane + 512 * ((j) >> 1) + 4 * ((j) & 1))
#define LN_DEC(hx, hy, l) (f32x4){__uint_as_float(((hx) << 16) | (((l) << 8) & 0xff00u) | 0x80u), __uint_as_float(((hx) & 0xffff0000u) | ((l) & 0xff00u) | 0x80u), \
                                  __uint_as_float(((hy) << 16) | (((l) >> 8) & 0xff00u) | 0x80u), __uint_as_float(((hy) & 0xffff0000u) | (((l) >> 16) & 0xff00u) | 0x80u)}
    f32x4 lg[8], lb[8];
#pragma unroll
    for (int j = 0; j < 8; ++j) { const int c = LN_C(j); lg[j] = *(const GAS f32x4*)(lng + c); lb[j] = *(const GAS f32x4*)(lnb + c); }
    struct Raw { v4u xh[4]; v2u xl[4]; f32x4 xf[8]; v4u y[4]; };
    auto fetch = [&](Raw& w, const int row) {
        const bf16* yr = Y + (size_t)row * D;
#pragma unroll
        for (int jj = 0; jj < 4; ++jj) { const int c2 = 8 * lane + 512 * jj;
            if (IN3) { w.xh[jj] = __builtin_nontemporal_load((const GAS v4u*)(XH + (size_t)row * D + c2)); w.xl[jj] = *(const GAS v2u*)(XL + (size_t)row * D + c2); }
            else { const float* xi = row < ML ? xin_lat + (size_t)row * D : xin_ctx + (size_t)(row - ML) * D; w.xf[2 * jj] = __builtin_nontemporal_load((const GAS f32x4*)(xi + c2)); w.xf[2 * jj + 1] = __builtin_nontemporal_load((const GAS f32x4*)(xi + c2 + 4)); }
            w.y[jj] = __builtin_nontemporal_load((const GAS v4u*)(yr + c2)); } };
    Raw cur;
    if (gw < nrows) fetch(cur, gw);
    for (int row = gw; row < nrows; row += NGW) {
        const int rr = row < ML ? (row >> 12) : 4;
        float* xo = row < ML ? xout_lat + (size_t)row * D : xout_ctx + (size_t)(row - ML) * D;
        const float* g0 = gate + (size_t)rr * NMODC;
        f32x4 za[8]; v4u ya[4];
#pragma unroll
        for (int jj = 0; jj < 4; ++jj) {
            if (IN3) { za[2 * jj] = LN_DEC(cur.xh[jj].x, cur.xh[jj].y, cur.xl[jj].x); za[2 * jj + 1] = LN_DEC(cur.xh[jj].z, cur.xh[jj].w, cur.xl[jj].y); }
            else { za[2 * jj] = cur.xf[2 * jj]; za[2 * jj + 1] = cur.xf[2 * jj + 1]; }
            ya[jj] = cur.y[jj]; }
        { const int rown = row + NGW; if (rown < nrows) fetch(cur, rown); }
        float sa = 0.f;
#pragma unroll
        for (int j = 0; j < 8; ++j) { const int c = LN_C(j); const f32x4 ga = *(const GAS f32x4*)(g0 + c);
            const unsigned ya0 = (j & 1) ? ya[j >> 1].z : ya[j >> 1].x, ya1 = (j & 1) ? ya[j >> 1].w : ya[j >> 1].y;
            za[j] = ALPHA * za[j] + s * ga * (f32x4){bflo(ya0), bfhi(ya0), bflo(ya1), bfhi(ya1)};
            sa += (za[j][0] + za[j][1]) + (za[j][2] + za[j][3]); }
#pragma unroll
        for (int o = 1; o < 64; o <<= 1) sa += __builtin_bit_cast(float, __builtin_amdgcn_ds_bpermute((lane ^ o) << 2, __builtin_bit_cast(int, sa)));
        const float ma = sa * (1.0f / D); float qa = 0.f;
#pragma unroll
        for (int j = 0; j < 8; ++j) { za[j] = za[j] - ma; qa += (za[j][0] * za[j][0] + za[j][1] * za[j][1]) + (za[j][2] * za[j][2] + za[j][3] * za[j][3]); }
#pragma unroll
        for (int o = 1; o < 64; o <<= 1) qa += __builtin_bit_cast(float, __builtin_amdgcn_ds_bpermute((lane ^ o) << 2, __builtin_bit_cast(int, qa)));
        const float rs = 1.0f / sqrtf(qa * (1.0f / D) + LN_EPS);
#pragma unroll
        for (int jj = 0; jj < 4; ++jj) { const int c2 = 8 * lane + 512 * jj;
            const f32x4 xa = za[2 * jj] * rs * lg[2 * jj] + lb[2 * jj], xb = za[2 * jj + 1] * rs * lg[2 * jj + 1] + lb[2 * jj + 1];
            if (OUT3) { const float x0 = xa[0], x1 = xa[1], x2 = xa[2], x3 = xa[3], x4 = xb[0], x5 = xb[1], x6 = xb[2], x7 = xb[3];
                const unsigned b0 = __float_as_uint(x0), b1 = __float_as_uint(x1), b2 = __float_as_uint(x2), b3 = __float_as_uint(x3), b4 = __float_as_uint(x4), b5 = __float_as_uint(x5), b6 = __float_as_uint(x6), b7 = __float_as_uint(x7);
                v4u hw; hw.x = (b0 >> 16) | (b1 & 0xffff0000u); hw.y = (b2 >> 16) | (b3 & 0xffff0000u); hw.z = (b4 >> 16) | (b5 & 0xffff0000u); hw.w = (b6 >> 16) | (b7 & 0xffff0000u);
                v2u lw; lw.x = ((b0 >> 8) & 0xffu) | (b1 & 0xff00u) | ((b2 << 8) & 0xff0000u) | ((b3 << 16) & 0xff000000u); lw.y = ((b4 >> 8) & 0xffu) | (b5 & 0xff00u) | ((b6 << 8) & 0xff0000u) | ((b7 << 16) & 0xff000000u);
                *(GAS v4u*)(XH + (size_t)row * D + c2) = hw; *(GAS v2u*)(XL + (size_t)row * D + c2) = lw; }
            else { *(GAS f32x4*)(xo + c2) = xa; *(GAS f32x4*)(xo + c2 + 4) = xb; }
            if (nsh) { const f32x4 sh0 = *(const GAS f32x4*)(nsh + (size_t)rr * NMODC + c2), sc0 = *(const GAS f32x4*)(nsc + (size_t)rr * NMODC + c2), sh1 = *(const GAS f32x4*)(nsh + (size_t)rr * NMODC + c2 + 4), sc1 = *(const GAS f32x4*)(nsc + (size_t)rr * NMODC + c2 + 4);
                const f32x4 h0 = xa * (1.0f + sc0) + sh0, h1 = xb * (1.0f + sc1) + sh1;
                v4u w; w.x = cvt_pk_bf16(h0[0], h0[1]); w.y = cvt_pk_bf16(h0[2], h0[3]); w.z = cvt_pk_bf16(h1[0], h1[1]); w.w = cvt_pk_bf16(h1[2], h1[3]); *(GAS v4u*)(H + (size_t)row * D + c2) = w; } }
    }
#undef LN_C
#undef LN_DEC
}

#define OPAQUE_S(x) asm volatile("" : "+s"(x))
#define PH_BEGIN() unsigned _sz; asm volatile("s_mov_b32 %0, 0" : "=s"(_sz)); int _vz; asm volatile("v_mov_b32 %0, 0" : "=v"(_vz)); \
    const Args* ap = (const Args*)((const char*)&args + _sz); unsigned char* wsp = ap->ws; int tid = wv0 * 64 + (int)__builtin_amdgcn_mbcnt_hi(~0u, __builtin_amdgcn_mbcnt_lo(~0u, (unsigned)_vz)); const int G = ap->grid; \
    const int bx = (int)blockIdx.x + (int)_sz, lane = tid & 63, wave = __builtin_amdgcn_readfirstlane(tid >> 6); const int vcu = (G % 8 == 0) ? (bx % 8) * (G / 8) + bx / 8 : bx; \
    const int gw = vcu * NWAVES + wave, NGW = G * NWAVES, gtid = vcu * (NWAVES * 64) + tid, NT = G * NWAVES * 64; (void)lane; (void)gw; (void)NGW; (void)gtid; (void)NT; (void)bx
#define GRID_BAR() do { unsigned _bz; asm volatile("s_mov_b32 %0, 0" : "=s"(_bz)); unsigned* _bp = (unsigned*)(args.ws + WS_CTL) + CW_BAR + _bz; XcdBarrier _b; _b.bar = _bp; _b.x = xb_xcc_id() + _bz; _b.G = (unsigned)((const Args*)((const char*)&args + _bz))->grid; \
        _b.st = (volatile LAS unsigned*)(lds + MISC_OFF) + 8; int _bv; asm volatile("v_mov_b32 %0, 0" : "=v"(_bv)); \
        xcd_barrier(_b, (wv0 * 64 + (int)__builtin_amdgcn_mbcnt_hi(~0u, __builtin_amdgcn_mbcnt_lo(~0u, (unsigned)_bv))) == 0); } while (0)

#define MODP ((float*)(wsp + WS_S0 + 9 * SLOT))
#define MOD ((float*)(wsp + WS_MOD))
#define AGG ((float*)(wsp + WS_AGG))
#define XCTX ((float*)(wsp + WS_XCTX))
#define SLOTP(k) ((bf16*)(wsp + WS_S0 + (size_t)(k) * SLOT))
#define Hb ((bf16*)(wsp + WS_H))
#define Yb ((bf16*)(wsp + WS_Y))
#define S0 SLOTP(0)
#define RGX SLOTP(0)
#define GG SLOTP(1)
#define SCB SLOTP(2)
#define SCX SLOTP(3)
#define SGR SLOTP(4)
#define SGS SLOTP(5)
#define XC SLOTP(6)
#define ASC SLOTP(7)
#define LAF SLOTP(8)
#define VF SLOTP(9)
#define LAB Hb
#define VB Yb
#define HLF SLOTP(0)
#define HLB SLOTP(2)
#define PF SLOTP(3)
#define PB SLOTP(6)
#define ARG SLOTP(2)
#define T1 SLOTP(9)
#define MG SLOTP(0)
#define ACT SLOTP(0)
#define PART3 ((float*)SLOTP(2))
#define PART5 ((float*)SLOTP(8))
#define PARTF ((float*)SLOTP(4))
#define MODL (MOD + (size_t)l * 5 * NMODC)

template <int LAYER, int HALF> __device__ __forceinline__ void ffn_block(const Args& args, LAS unsigned char* lds, const int wv0) {
    constexpr int l = LAYER, half = HALF;
            const int sub = half * 2;
#ifndef SKIP_FUP
            { PH_BEGIN(); pg8::Gemm g{Hb, (const bf16*)(wsp + (half ? W_2IN : W_1IN))}; pg8::Sched<2 * DFF / 256> S; S.init(G, bx, (l == DEPTH - 1 && half == 1) ? ML / 256 : NPAN);
              pg8::EpiSwiGLU E{ACT, DFF};
              pg8::gemm_phase<pg8::EpiSwiGLU, true, D, D, D, 0, 0, 0>(lds + RING_OFF, g, S, E, tid);
              if (l == 0) {
                  const int ntile = NPAN * (2 * DFF / 256), nbusy = ntile - (ntile / G) * G;
                  if (nbusy > 0 && bx >= nbusy) { asm volatile("s_waitcnt vmcnt(0)" ::: "memory"); __syncthreads();
                      convert_weights(*ap, half == 0 ? 0 : 1, half == 0 ? CV_FIRST : 0, (half == 0 ? CV_FIRST : 0) + CV_UP, 0, wsp, lds, (bx - nbusy) * NWAVES + wave, (G - nbusy) * NWAVES, wave, lane); } } }
            GRID_BAR();
#endif
#ifndef SKIP_FDN
            { PH_BEGIN(); pg8::Gemm g{ACT, (const bf16*)(wsp + (half ? (l == DEPTH - 1 ? W_2OUT_ALT : W_2OUT) : W_1OUT))}; pg8::Sched<D / 256> S; S.init(G, bx, ML / 256);
              pg8::EpiPlain E{Yb, D};
              pg8::gemm_phase<pg8::EpiPlain, true, DFF, DFF, DFF, 0, 0, 0>(lds + RING_OFF, g, S, E, tid); }
            if (!(l == DEPTH - 1 && half == 1)) {
              PH_BEGIN(); pg8::Gemm g2{ACT + (size_t)ML * DFF, (const bf16*)(wsp + (half ? W_2OUT : W_1OUT))}; pg8::Sched<32> S2; S2.init(G, bx, MC / 256);
              pg8::EpiPartial<false> E2{PARTF, nullptr, ML};
              pg8::gemm_phase<pg8::EpiPartial<false>, true, DFF, DFF, DFF / 4, 8, DFF / 4, 8>(lds + RING_OFF, g2, S2, E2, tid); }
            if (l == 0) {
              PH_BEGIN(); __syncthreads();
              const int nsplit = (MC / 256) * 32 < G ? (MC / 256) * 32 : G;
              const int NW = (nsplit + 2 * (G - nsplit)) * NWAVES;
              const int lo = (half == 0 ? CV_FIRST : 0) + CV_UP, lyr = half == 0 ? 0 : 1, alt = half == 0 ? 0 : 1;
              if (bx < nsplit) convert_weights(*ap, lyr, lo, CV_ALL, alt, wsp, lds, bx * NWAVES + wave, NW, wave, lane);
              else { const int w0 = nsplit * NWAVES + ((bx - nsplit) * NWAVES + wave) * 2;
                  convert_weights(*ap, lyr, lo, CV_ALL, alt, wsp, lds, w0, NW, wave, lane); convert_weights(*ap, lyr, lo, CV_ALL, alt, wsp, lds, w0 + 1, NW, wave, lane); } }
            GRID_BAR();
#endif
#ifndef SKIP_LNF
            { PH_BEGIN(); const bool first = (l == 0 && half == 0);
              const float* nsh = nullptr; const float* nsc = nullptr;
              if (half == 0) { nsh = MODL + 3 * D; nsc = MODL + 4 * D; } else if (l + 1 < DEPTH) { nsh = MODL + 5 * NMODC; nsc = MODL + 5 * NMODC + D; }
              ln_phase<!(LAYER == 0 && HALF == 0), !(LAYER == DEPTH - 1 && HALF == 1)>(ap->in[I_X], ap->in[I_CTX], ap->out, nullptr, (unsigned short*)(wsp + WS_XHI), wsp + WS_XLO, Yb, MODL + (2 + 3 * sub) * D, 0.5f,
                       ap->in[I_LNG] + (size_t)(l * 3 + sub) * D, ap->in[I_LNB] + (size_t)(l * 3 + sub) * D, nsh, nsc, Hb, gw, NGW, lane, (l == DEPTH - 1 && half == 1) ? ML : M, (l == DEPTH - 1 && half == 1) ? (const float*)nullptr : (const float*)PARTF); }
            if (!(l == DEPTH - 1 && half == 1)) GRID_BAR();
#endif
}


constexpr int RG_PITCH = 272, RG_T_OFF = 256 * RG_PITCH;
typedef short rg_bf16x8 __attribute__((ext_vector_type(8)));
struct RgAcc { f32x4 xr, xi, uu; };
__device__ __forceinline__ RgAcc rg_mma(LAS unsigned char* lds, const int m, const rg_bf16x8 (&Br)[4], const rg_bf16x8 (&Bi)[4], const rg_bf16x8 Bid, const int wave, const int q, const int cl) {
    typedef rg_bf16x8 bf16x8;
    bf16x8 a[4];
#pragma unroll
    for (int ks = 0; ks < 4; ++ks) a[ks] = *(const LAS bf16x8*)(lds + (16 * m + cl) * RG_PITCH + 64 * ks + 16 * q);
    const bf16x8 au = *(const LAS bf16x8*)(lds + (16 * m + cl) * RG_PITCH + 64 * (wave >> 1) + 16 * q);
    RgAcc r; r.xr = (f32x4){0.f, 0.f, 0.f, 0.f}; r.xi = r.xr;
#pragma unroll
    for (int ks = 0; ks < 4; ++ks) { r.xr = __builtin_amdgcn_mfma_f32_16x16x32_bf16(a[ks], Br[ks], r.xr, 0, 0, 0); r.xi = __builtin_amdgcn_mfma_f32_16x16x32_bf16(a[ks], Bi[ks], r.xi, 0, 0, 0); }
    r.uu = __builtin_amdgcn_mfma_f32_16x16x32_bf16(au, Bid, (f32x4){0.f, 0.f, 0.f, 0.f}, 0, 0, 0);
    return r;
}
struct RgGate { float ea[4], vv[4]; };
typedef float rg_f32x2 __attribute__((ext_vector_type(2)));
__device__ __forceinline__ RgGate rg_act(const RgAcc& c, const float nbr, const float nbi, const float ls2) {
    constexpr float LOG2E = 1.4426950408889634f;
    RgGate g;
#pragma unroll
    for (int h = 0; h < 2; ++h) {
        const rg_f32x2 xr = {c.xr[2 * h], c.xr[2 * h + 1]}, xi = {c.xi[2 * h], c.xi[2 * h + 1]}, uu = {c.uu[2 * h], c.uu[2 * h + 1]};
        const rg_f32x2 tr = xr * (-LOG2E) + nbr, ti = xi * (-LOG2E) + nbi;
        rg_f32x2 er = {__builtin_amdgcn_exp2f(tr.x), __builtin_amdgcn_exp2f(tr.y)}, ei = {__builtin_amdgcn_exp2f(ti.x), __builtin_amdgcn_exp2f(ti.y)};
        er = er + 1.0f; ei = ei + 1.0f;
        const rg_f32x2 rg = {__builtin_amdgcn_rcpf(er.x), __builtin_amdgcn_rcpf(er.y)}, ig = {__builtin_amdgcn_rcpf(ei.x), __builtin_amdgcn_rcpf(ei.y)};
        const rg_f32x2 la = rg * ls2;
        const rg_f32x2 e = {__builtin_amdgcn_exp2f(la.x), __builtin_amdgcn_exp2f(la.y)};
        const rg_f32x2 om = 1.0f - e * e;
        const rg_f32x2 sq = {__builtin_amdgcn_sqrtf(om.x), __builtin_amdgcn_sqrtf(om.y)};
        const rg_f32x2 v = sq * (ig * uu);
        g.ea[2 * h] = e.x; g.ea[2 * h + 1] = e.y; g.vv[2 * h] = v.x; g.vv[2 * h + 1] = v.y; }
    return g;
}
constexpr int CW_T1F = 800;
constexpr int CW_RGF = 512;
template <int d> __device__ __forceinline__ void rg_scan1(const bool add, const RgGate& g, float& hin, float& Acum, unsigned& P01, unsigned& P23, unsigned& H01, unsigned& H23, const int lane, const int q, const int cl) {
    const int s1 = (d ? lane + 16 : lane - 16) & 63, s2 = (d ? lane + 32 : lane - 32) & 63, st = d ? cl : 48 + cl;
    const bool v1 = d ? (q < 3) : (q >= 1), v2 = d ? (q < 2) : (q >= 2);
    const int f0 = d ? 3 : 0, f1 = d ? 2 : 1, f2 = d ? 1 : 2, f3 = d ? 0 : 3;
    float A = g.ea[f0] * g.ea[f1], H = g.ea[f1] * g.vv[f0] + g.vv[f1];
    A *= g.ea[f2]; H = g.ea[f2] * H + g.vv[f2]; A *= g.ea[f3]; H = g.ea[f3] * H + g.vv[f3];
#define RG_BP(src, x) __builtin_bit_cast(float, __builtin_amdgcn_ds_bpermute((src) << 2, __builtin_bit_cast(int, (x))))
    float Ap = RG_BP(s1, A), Hp = RG_BP(s1, H); if (!v1) { Ap = 1.f; Hp = 0.f; }
    const float A1 = A * Ap, H1 = A * Hp + H;
    float Ap2 = RG_BP(s2, A1), Hp2 = RG_BP(s2, H1); if (!v2) { Ap2 = 1.f; Hp2 = 0.f; }
    const float A2 = A1 * Ap2, H2 = A1 * Hp2 + H1;
    float Ae = RG_BP(s1, A2), He = RG_BP(s1, H2); if (!v1) { Ae = 1.f; He = 0.f; }
    const float At = RG_BP(st, A2), Ht = RG_BP(st, H2);
#undef RG_BP
    float hs = Ae * hin + He, pc = Ae * Acum;
    float ho[4], po[4];
    hs = g.ea[f0] * hs + g.vv[f0]; ho[f0] = hs; pc *= g.ea[f0]; po[f0] = pc;
    hs = g.ea[f1] * hs + g.vv[f1]; ho[f1] = hs; pc *= g.ea[f1]; po[f1] = pc;
    hs = g.ea[f2] * hs + g.vv[f2]; ho[f2] = hs; pc *= g.ea[f2]; po[f2] = pc;
    hs = g.ea[f3] * hs + g.vv[f3]; ho[f3] = hs; pc *= g.ea[f3]; po[f3] = pc;
    P01 = cvt_pk_bf16(po[0], po[1]); P23 = cvt_pk_bf16(po[2], po[3]);
    asm volatile("" : "+v"(P01), "+v"(P23));
    if (add) { ho[0] += bflo(H01); ho[1] += bfhi(H01); ho[2] += bflo(H23); ho[3] += bfhi(H23); }
    H01 = cvt_pk_bf16(ho[0], ho[1]); H23 = cvt_pk_bf16(ho[2], ho[3]);
    asm volatile("" : "+v"(H01), "+v"(H23));
    hin = At * hin + Ht; Acum *= At;
}
template <int LAYER, int NTL> __device__ __forceinline__ void rg_unit(const Args& args, LAS unsigned char* lds, const int wv0, v4u (&xw)[NTL / 2],
                                                                       const int row0, const int hd, const int b, const int ci, const int pf, const int pb, const int g, const bool has_next, const int row0n, const int hdn) {
    constexpr int l = LAYER;
    typedef rg_bf16x8 bf16x8;
    constexpr float LOG2E = 1.4426950408889634f;
    constexpr bool CTX = NTL == 4;
    PH_BEGIN();
    const int q = lane >> 4, cl = lane & 15;
    const float* gbl = ap->in[I_RGGB] + (size_t)l * 4 * D;
    const float* ls8l = (const float*)(wsp + WS_LS8) + (size_t)l * 2 * D;
    unsigned* flgL = (unsigned*)(wsp + WS_CTL) + CW_RGF + l * 128;
    unsigned* flgC = flgL + 64;
    unsigned* bar = (unsigned*)(wsp + WS_CTL) + CW_BAR;
    const int r0x = tid >> 4, c16x = tid & 15, vxx = (r0x * D + c16x * 8) * 2;
    const int chl = wave * 16 + cl, ch = hd * 128 + chl;
    __syncthreads();
#pragma unroll
    for (int i = 0; i < NTL / 2; ++i) *(LAS v4u*)(lds + (r0x + 32 * i) * RG_PITCH + c16x * 16) = xw[i];
    bf16x8 Bid;
    { const int kl = 16 * (wave & 1) + cl; const bool mine = (kl >> 3) == q;
#pragma unroll
      for (int jj = 0; jj < 8; ++jj) Bid[jj] = (mine && (kl & 7) == jj) ? (short)0x3F80 : (short)0; }
    const bf16* wg = (const bf16*)(wsp + W_G2) + ((size_t)((hd * 2) * 256) + chl) * 128 + 8 * q;
    const float nbr0 = -LOG2E * gbl[(size_t)0 * D + ch], nbi0 = -LOG2E * gbl[(size_t)1 * D + ch], ls20 = LOG2E * ls8l[ch];
    const float nbr1 = -LOG2E * gbl[(size_t)2 * D + ch], nbi1 = -LOG2E * gbl[(size_t)3 * D + ch], ls21 = LOG2E * ls8l[(size_t)D + ch];
    bf16x8 Br[4], Bi[4];
#pragma unroll
    for (int ks = 0; ks < 4; ++ks) { Br[ks] = *(const GAS bf16x8*)(wg + 32 * ks); Bi[ks] = *(const GAS bf16x8*)(wg + 128 * 128 + 32 * ks); }
    __syncthreads();
    unsigned Pf[NTL][2], Pb[NTL][2], Hs[NTL][2];
    float hin0 = 0.f, hin1 = 0.f, Ls0 = 1.f, Ls1 = 1.f;
    if (wave >= 4) __builtin_amdgcn_s_sleep(8);
    {
        RgAcc acc = rg_mma(lds, 0, Br, Bi, Bid, wave, q, cl);
#pragma unroll
        for (int mm = 0; mm < NTL; ++mm) {
            RgAcc nxt = acc;
            if (mm < NTL - 1) nxt = rg_mma(lds, mm + 1, Br, Bi, Bid, wave, q, cl);
            const RgGate fa = rg_act(acc, nbr0, nbi0, ls20);
            rg_scan1<0>(false, fa, hin0, Ls0, Pf[mm][0], Pf[mm][1], Hs[mm][0], Hs[mm][1], lane, q, cl);
            asm volatile("" ::: "memory"); __builtin_amdgcn_sched_barrier(0);
            acc = nxt;
        }
    }
#pragma unroll
    for (int ks = 0; ks < 4; ++ks) { Br[ks] = *(const GAS bf16x8*)(wg + 256 * 128 + 32 * ks); Bi[ks] = *(const GAS bf16x8*)(wg + 256 * 128 + 128 * 128 + 32 * ks); }
    {
        RgAcc acc = rg_mma(lds, NTL - 1, Br, Bi, Bid, wave, q, cl);
#pragma unroll
        for (int mm = 0; mm < NTL; ++mm) {
            RgAcc nxt = acc;
            if (mm < NTL - 1) nxt = rg_mma(lds, NTL - 2 - mm, Br, Bi, Bid, wave, q, cl);
            const RgGate fb = rg_act(acc, nbr1, nbi1, ls21);
            rg_scan1<1>(true, fb, hin1, Ls1, Pb[NTL - 1 - mm][0], Pb[NTL - 1 - mm][1], Hs[NTL - 1 - mm][0], Hs[NTL - 1 - mm][1], lane, q, cl);
            asm volatile("" ::: "memory"); __builtin_amdgcn_sched_barrier(0);
            acc = nxt;
        }
    }
    if (q == 0) { AGG[(size_t)((ci * 2 + 0) * 2) * D + ch] = Ls0; AGG[(size_t)((ci * 2 + 0) * 2 + 1) * D + ch] = hin0; AGG[(size_t)((ci * 2 + 1) * 2) * D + ch] = Ls1; AGG[(size_t)((ci * 2 + 1) * 2 + 1) * D + ch] = hin1; }
    asm volatile("s_waitcnt vmcnt(0)" ::: "memory");
    __syncthreads();
    if (tid == 0) { __builtin_amdgcn_fence(__ATOMIC_RELEASE, "agent"); asm volatile("s_waitcnt vmcnt(0)" ::: "memory"); (void)xb_add(CTX ? &flgC[g] : &flgL[g], 1u); }
    const bool need_out = !(l == DEPTH - 1 && CTX);
    if (has_next) { const __amdgpu_buffer_rsrc_t rX = __builtin_amdgcn_make_buffer_rsrc((void*)(XC + (size_t)row0n * D + hdn * 128), 0, 16 * NTL * D * 2, 0x00020000);
#pragma unroll
        for (int i = 0; i < NTL / 2; ++i) xw[i] = __builtin_amdgcn_raw_buffer_load_b128(rX, vxx, (32 * i * D) * 2, 0); }
    const int vgo = vxx;
    v4u ggw[NTL / 2];
    if (need_out) { const __amdgpu_buffer_rsrc_t rG = __builtin_amdgcn_make_buffer_rsrc((void*)(GG + (size_t)row0 * D + hd * 128), 0, 16 * NTL * D * 2, 0x00020000);
#pragma unroll
        for (int i = 0; i < NTL / 2; ++i) ggw[i] = __builtin_amdgcn_raw_buffer_load_b128(rG, vgo, (32 * i * D) * 2, 0); }
    if (need_out) {
        if (tid == 0) { if (!CTX) XB_SPIN(xb_ld(&flgL[g]) < 16u, bar); XB_SPIN(xb_ld(&flgC[g]) < 4u, bar); __builtin_amdgcn_fence(__ATOMIC_ACQUIRE, "agent"); asm volatile("s_waitcnt vmcnt(0)" ::: "memory"); }
        __syncthreads();
        constexpr int NFOLD = CTX ? 3 : 19;
        const int dd = q & 1, mypos = dd ? pb : pf;
        const __amdgpu_buffer_rsrc_t rA = __builtin_amdgcn_make_buffer_rsrc((void*)AGG, 0, 80 * 4 * D * 4, 0x00020000);
        const int va = (dd * 2 * D + ch) * 4;
        float Lc[NFOLD], Hc[NFOLD];
#pragma unroll
        for (int t = 0; t < NFOLD; ++t) { const int cfw = (t < 4) ? 64 + 4 * b + t : 16 * b + (t - 4), cbw = (t < 4) ? 64 + 4 * b + (3 - t) : 16 * b + (19 - t);
            const int vo = va + (dd ? cbw : cfw) * (4 * D * 4); const bool ok = t < mypos;
            const float lv = __builtin_bit_cast(float, __builtin_amdgcn_raw_buffer_load_b32(rA, vo, 0, 0)), hv = __builtin_bit_cast(float, __builtin_amdgcn_raw_buffer_load_b32(rA, vo, D * 4, 0));
            Lc[t] = ok ? lv : 1.f; Hc[t] = ok ? hv : 0.f; }
        float c = 0.f;
#pragma unroll
        for (int t = 0; t < NFOLD; ++t) c = Lc[t] * c + Hc[t];
        const float cf = __builtin_bit_cast(float, __builtin_amdgcn_ds_bpermute(cl << 2, __builtin_bit_cast(int, c)));
        const float cb = __builtin_bit_cast(float, __builtin_amdgcn_ds_bpermute((16 + cl) << 2, __builtin_bit_cast(int, c)));
#pragma unroll
        for (int m = 0; m < NTL; ++m) {
#pragma unroll
            for (int k = 0; k < 2; ++k) { const unsigned pfw = Pf[m][k], pbw = Pb[m][k], hh = Hs[m][k];
                Hs[m][k] = cvt_pk_bf16(bflo(hh) + bflo(pfw) * cf + bflo(pbw) * cb, bfhi(hh) + bfhi(pfw) * cf + bfhi(pbw) * cb); } }
#pragma unroll
        for (int m = 0; m < NTL; ++m) {
#pragma unroll
            for (int k = 0; k < 2; ++k) { LAS unsigned short* t0 = (LAS unsigned short*)(lds + RG_T_OFF + (16 * m + 4 * q + 2 * k) * RG_PITCH + chl * 2); LAS unsigned short* t1 = (LAS unsigned short*)(lds + RG_T_OFF + (16 * m + 4 * q + 2 * k + 1) * RG_PITCH + chl * 2);
                const unsigned w = Hs[m][k]; *t0 = (unsigned short)(w & 0xffffu); *t1 = (unsigned short)(w >> 16); } }
        __syncthreads();
        const __amdgpu_buffer_rsrc_t rO = __builtin_amdgcn_make_buffer_rsrc((void*)(ARG + (size_t)row0 * D + hd * 128), 0, 16 * NTL * D * 2, 0x00020000);
#pragma unroll
        for (int i = 0; i < NTL / 2; ++i) { const int r = r0x + 32 * i;
            const v4u hw = *(const LAS v4u*)(lds + RG_T_OFF + r * RG_PITCH + c16x * 16), gw = ggw[i];
            v4u o; o.x = cvt_pk_bf16(bflo(hw.x) * bflo(gw.x), bfhi(hw.x) * bfhi(gw.x)); o.y = cvt_pk_bf16(bflo(hw.y) * bflo(gw.y), bfhi(hw.y) * bfhi(gw.y));
            o.z = cvt_pk_bf16(bflo(hw.z) * bflo(gw.z), bfhi(hw.z) * bfhi(gw.z)); o.w = cvt_pk_bf16(bflo(hw.w) * bflo(gw.w), bfhi(hw.w) * bfhi(gw.w));
            __builtin_amdgcn_raw_buffer_store_b128(o, rO, vgo, (32 * i * D) * 2, 0); }
    }
}
template <int LAYER> __device__ __forceinline__ void rg_phase1(const Args& args, LAS unsigned char* lds, const int wv0) {
    unsigned _sz; asm volatile("s_mov_b32 %0, 0" : "=s"(_sz));
    const int bx = (int)blockIdx.x + (int)_sz;
    int _vz; asm volatile("v_mov_b32 %0, 0" : "=v"(_vz));
    const int tid = wv0 * 64 + (int)__builtin_amdgcn_mbcnt_hi(~0u, __builtin_amdgcn_mbcnt_lo(~0u, (unsigned)_vz));
    unsigned char* wsp = ((const Args*)((const char*)&args + _sz))->ws;
    const int r0x = tid >> 4, c16x = tid & 15, vxx = (r0x * D + c16x * 8) * 2;
    const int gC = bx >> 2, kC = bx & 3, bC = gC >> 4, hdC = gC & 15, rowC = ML + bC * 256 + 64 * kC;
    const int slot = bx >> 4, mi = bx & 15;
    v4u xwC[2], xwL[8];
    { const __amdgpu_buffer_rsrc_t rX = __builtin_amdgcn_make_buffer_rsrc((void*)(XC + (size_t)rowC * D + hdC * 128), 0, 64 * D * 2, 0x00020000);
#pragma unroll
      for (int i = 0; i < 2; ++i) xwC[i] = __builtin_amdgcn_raw_buffer_load_b128(rX, vxx, (32 * i * D) * 2, 0); }
    { const int g = slot, b = g >> 4, hd = g & 15, p = 16 * b + mi;
      const __amdgpu_buffer_rsrc_t rX = __builtin_amdgcn_make_buffer_rsrc((void*)(XC + (size_t)p * 256 * D + hd * 128), 0, 256 * D * 2, 0x00020000);
#pragma unroll
      for (int i = 0; i < 8; ++i) xwL[i] = __builtin_amdgcn_raw_buffer_load_b128(rX, vxx, (32 * i * D) * 2, 0); }
    rg_unit<LAYER, 4>(args, lds, wv0, xwC, rowC, hdC, bC, 64 + 4 * bC + kC, kC, 3 - kC, gC, false, 0, 0);
    for (int g = slot; g < 64; g += 16) {
        const int b = g >> 4, hd = g & 15, p = 16 * b + mi;
        const int g2 = g + 16, p2 = 16 * (g2 >> 4) + mi;
        rg_unit<LAYER, 16>(args, lds, wv0, xwL, p * 256, hd, b, p, 4 + mi, 19 - mi, g, g2 < 64, p2 * 256, g2 & 15);
    }
}

template <int LAYER> __device__ __forceinline__ void mixer_block(const Args& args, LAS unsigned char* lds, const int wv0) {
    constexpr int l = LAYER, half = 0; (void)half;
#ifndef SKIP_M1
            { PH_BEGIN(); pg8::Gemm g{Hb, (const bf16*)(wsp + W_IN)}; pg8::Sched<PROJ_W / 256> S; S.init(G, bx, NPAN);
              pg8::EpiProj E{S0, SLOT_ELEMS, ap->in[I_BMERGE] + (size_t)l * 2 * D};
              pg8::gemm_phase<pg8::EpiProj, true, D, D, D, 0, 0, 0>(lds + RING_OFF, g, S, E, tid); }
            GRID_BAR();
#endif
#ifndef SKIP_M2A
            {
                PH_BEGIN();
                const int cg = gtid & 255, ch = cg * 8;
                float wr_[4][8], ws_[3][8], bb[8];
                const float* rcw = ap->in[I_RGCW] + (size_t)l * 4 * D; const float* scw = ap->in[I_SCCW] + (size_t)l * 3 * D; const float* rcb = ap->in[I_RGCB] + (size_t)l * D;
#pragma unroll
                for (int j = 0; j < 8; ++j) { bb[j] = rcb[ch + j];
#pragma unroll
                    for (int k = 0; k < 4; ++k) wr_[k][j] = rcw[k * D + ch + j];
#pragma unroll
                    for (int k = 0; k < 3; ++k) ws_[k][j] = scw[k * D + ch + j]; }
                for (int rowA = gtid >> 8; rowA < M; rowA += NT >> 7) {
                    const int rowB = rowA + (NT >> 8); const bool two = rowB < M;
                    v4u xr[2][4], xs[2][3], bw[2]; const v4u zero4 = {(unsigned)_vz, (unsigned)_vz, (unsigned)_vz, (unsigned)_vz};
#pragma unroll
                    for (int t = 0; t < 2; ++t) { const int row = t ? (two ? rowB : rowA) : rowA;
                        int q0, q1; if (row < ML) { q0 = row & ~63; q1 = q0 + 64; } else { q0 = row & ~255; q1 = q0 + 256; }
#pragma unroll
                        for (int k = 0; k < 4; ++k) { const int rr = row + k - 2; xr[t][k] = (rr >= q0 && rr < q1) ? *(const GAS v4u*)(RGX + (size_t)rr * D + ch) : zero4; }
#pragma unroll
                        for (int k = 0; k < 3; ++k) { const int rr = row + k - 1; xs[t][k] = (rr >= q0 && rr < q1) ? *(const GAS v4u*)(SCX + (size_t)rr * D + ch) : zero4; }
                        bw[t] = *(const GAS v4u*)(SCB + (size_t)row * D + ch); }
#pragma unroll
                    for (int t = 0; t < 2; ++t) { if (t == 1 && !two) break; const int row = t ? rowB : rowA;
                        float a[8], c2[8];
#pragma unroll
                        for (int j = 0; j < 8; ++j) { a[j] = bb[j]; c2[j] = 0.f; }
#pragma unroll
                        for (int k = 0; k < 4; ++k) { const v4u xw = xr[t][k];
                            a[0] += wr_[k][0] * bflo(xw.x); a[1] += wr_[k][1] * bfhi(xw.x); a[2] += wr_[k][2] * bflo(xw.y); a[3] += wr_[k][3] * bfhi(xw.y);
                            a[4] += wr_[k][4] * bflo(xw.z); a[5] += wr_[k][5] * bfhi(xw.z); a[6] += wr_[k][6] * bflo(xw.w); a[7] += wr_[k][7] * bfhi(xw.w); }
#pragma unroll
                        for (int k = 0; k < 3; ++k) { const v4u xw = xs[t][k];
                            c2[0] += ws_[k][0] * bflo(xw.x); c2[1] += ws_[k][1] * bfhi(xw.x); c2[2] += ws_[k][2] * bflo(xw.y); c2[3] += ws_[k][3] * bfhi(xw.y);
                            c2[4] += ws_[k][4] * bflo(xw.z); c2[5] += ws_[k][5] * bfhi(xw.z); c2[6] += ws_[k][6] * bflo(xw.w); c2[7] += ws_[k][7] * bfhi(xw.w); }
                        v4u o; o.x = cvt_pk_bf16(a[0], a[1]); o.y = cvt_pk_bf16(a[2], a[3]); o.z = cvt_pk_bf16(a[4], a[5]); o.w = cvt_pk_bf16(a[6], a[7]);
                        *(GAS v4u*)(XC + (size_t)row * D + ch) = o;
                        o.x = cvt_pk_bf16(c2[0] * bflo(bw[t].x), c2[1] * bfhi(bw[t].x)); o.y = cvt_pk_bf16(c2[2] * bflo(bw[t].y), c2[3] * bfhi(bw[t].y));
                        o.z = cvt_pk_bf16(c2[4] * bflo(bw[t].z), c2[5] * bfhi(bw[t].z)); o.w = cvt_pk_bf16(c2[6] * bflo(bw[t].w), c2[7] * bfhi(bw[t].w));
                        *(GAS v4u*)(ASC + (size_t)row * D + ch) = o; }
                }
            }
            GRID_BAR();
#endif
            rg_phase1<LAYER>(args, lds, wv0);
            GRID_BAR();
#ifndef SKIP_M3
            { PH_BEGIN(); pg8::Gemm g{ARG, (const bf16*)(wsp + W_RG)}; pg8::SchedX<D / 256> S; S.init(G, bx, (l == DEPTH - 1) ? ML / 256 : NPAN, 0, nullptr, 0u);
              pg8::EpiGated<false> E{T1, SGR, nullptr, nullptr, 0};
              pg8::gemm_phase<pg8::EpiGated<false>, true, D, D, D, 0, 0, 0>(lds + RING_OFF, g, S, E, tid);
              asm volatile("s_waitcnt vmcnt(0)" ::: "memory"); __syncthreads();
              const int ntile = ((l == DEPTH - 1) ? ML / 256 : NPAN) * (D / 256), ntail = ntile - (ntile / G) * G;
              if (bx < ntail && tid == 0) { __builtin_amdgcn_fence(__ATOMIC_RELEASE, "agent"); asm volatile("s_waitcnt vmcnt(0)" ::: "memory"); (void)xb_add((unsigned*)(wsp + WS_CTL) + CW_T1F + l, 1u); } }
#endif
#ifndef SKIP_M4
            { PH_BEGIN(); const int ntile = ((l == DEPTH - 1) ? ML / 256 : NPAN) * (D / 256), ntail = ntile - (ntile / G) * G;
              pg8::Gemm g{ASC, (const bf16*)(wsp + W_SC)}; pg8::SchedX<D / 256> S; S.init(G, bx, (l == DEPTH - 1) ? ML / 256 : NPAN, (ntail > 0 && 2 * ntail <= G) ? ntail : 0, (unsigned*)(wsp + WS_CTL) + CW_T1F + l, (unsigned)ntail);
              pg8::EpiGated<true> E{MG, SGS, T1, (const float*)nullptr, ML};
              pg8::gemm_phase<pg8::EpiGated<true>, true, D, D, D, 0, 0, 0>(lds + RING_OFF, g, S, E, tid); }
            GRID_BAR();
#endif
#ifndef SKIP_M5
            { PH_BEGIN(); pg8::Gemm g{MG, (const bf16*)(wsp + W_O)}; pg8::Sched<D / 256> S; S.init(G, bx, ML / 256);
              pg8::EpiPlain E{Yb, D};
              pg8::gemm_phase<pg8::EpiPlain, true, D, D, D, 0, 0, 0>(lds + RING_OFF, g, S, E, tid); }
            if (l < DEPTH - 1) {
              PH_BEGIN(); pg8::Gemm g2{MG + (size_t)ML * D, (const bf16*)(wsp + W_O)}; pg8::Sched<32> S2; S2.init(G, bx, MC / 256);
              pg8::EpiPartial<false> E2{PART5, nullptr, ML};
              pg8::gemm_phase<pg8::EpiPartial<false>, true, D, D, D / 4, 8, D / 4, 8>(lds + RING_OFF, g2, S2, E2, tid); }
            GRID_BAR();
#endif
#ifndef SKIP_M6
            { PH_BEGIN();
            ln_phase<true, true>(nullptr, nullptr, nullptr, nullptr, (unsigned short*)(wsp + WS_XHI), wsp + WS_XLO, Yb, MODL + 5 * D, 1.0f, ap->in[I_LNG] + (size_t)(l * 3 + 1) * D, ap->in[I_LNB] + (size_t)(l * 3 + 1) * D,
                     MODL + 6 * D, MODL + 7 * D, Hb, gw, NGW, lane, (l == DEPTH - 1) ? ML : M, (l < DEPTH - 1) ? (const float*)PART5 : (const float*)nullptr); }
            GRID_BAR();
#endif
}

__global__ void __launch_bounds__(NWAVES * 64, 2) fwd_kernel(Args args) {
    extern __shared__ __attribute__((aligned(16))) unsigned char lds_raw[];
    LAS unsigned char* lds = (LAS unsigned char*)lds_raw;
    volatile LAS unsigned* MISC = (volatile LAS unsigned*)(lds + MISC_OFF);
    const int wv0 = __builtin_amdgcn_readfirstlane((int)threadIdx.x >> 6);
    for (int u = threadIdx.x; u < (LDS_BYTES - LDSCTL_OFF) / 4; u += NWAVES * 64) ((LAS unsigned*)(lds + LDSCTL_OFF))[u] = 0u;
    __syncthreads();
    (void)xcd_barrier_post((unsigned*)(args.ws + WS_CTL) + CW_BAR, MISC + 8);
#ifndef SKIP_P0
    {
        PH_BEGIN();
        LAS float* tab = (LAS float*)(lds + 69632);
        for (int i = tid; i < 5 * D; i += NWAVES * 64) { const int r = i >> 11, k = i & 2047; const float v = r < 4 ? ap->in[I_C][r * D + k] : ap->in[I_CCTX][k]; tab[i] = v * pg8::sigmoidf_(v); }
        __syncthreads();
        for (int it = gw; it < 144 * 16; it += NGW) {
            const int s = it & 15, g = it >> 4, l = g / 72, col = (g - l * 72) * 256 + lane * 4;
            const float* W = ap->in[I_WMOD] + (size_t)l * D * NMODC + (size_t)(s * 128) * NMODC + col;
            const LAS float* tb = tab + s * 128;
            f32x4 a0 = {0.f, 0.f, 0.f, 0.f}, a1 = a0, a2 = a0, a3 = a0, a4 = a0;
            for (int k = 0; k < 128; k += 16) { f32x4 w[16];
#pragma unroll
                for (int j = 0; j < 16; ++j) w[j] = *(const GAS f32x4*)(W + (size_t)(k + j) * NMODC);
#pragma unroll
                for (int j = 0; j < 16; ++j) { a0 += tb[k + j] * w[j]; a1 += tb[2048 + k + j] * w[j]; a2 += tb[4096 + k + j] * w[j]; a3 += tb[6144 + k + j] * w[j]; a4 += tb[8192 + k + j] * w[j]; } }
            float* o = MODP + (size_t)(s * 5) * (2 * NMODC) + l * NMODC + col;
            *(GAS f32x4*)o = a0; *(GAS f32x4*)(o + (size_t)2 * NMODC) = a1; *(GAS f32x4*)(o + (size_t)4 * NMODC) = a2; *(GAS f32x4*)(o + (size_t)6 * NMODC) = a3; *(GAS f32x4*)(o + (size_t)8 * NMODC) = a4;
        }
        for (int i = gtid; i < DEPTH * 2 * D; i += NT) { const float ex = __expf(-ap->in[I_RGLAM][i]);
            const float lp = ex < 0.05f ? ex * (1.0f - ex * (0.5f - ex * (0.33333333f - 0.25f * ex))) : __logf(1.0f + ex);
            ((float*)(wsp + WS_LS8))[i] = -8.0f * lp; }
        __syncthreads();
        convert_weights(*ap, 0, 0, CV_FIRST, 0, wsp, lds, gw, NGW, wave, lane);
    }
    GRID_BAR();
#endif
#ifndef SKIP_P1A
    { PH_BEGIN();
    for (int i = gtid; i < 2 * 5 * NMODC; i += NT) { const int n = i % NMODC, r = (i / NMODC) % 5, l = i / (5 * NMODC);
        float v = ap->in[I_BMOD][l * NMODC + n];
#pragma unroll
        for (int s = 0; s < 16; ++s) v += MODP[(size_t)(s * 5 + r) * (2 * NMODC) + l * NMODC + n];
        MOD[i] = v; } }
    GRID_BAR();
#endif
#ifndef SKIP_P1B
    { PH_BEGIN();
    for (int row = gw; row < M; row += NGW) {
        const int r = row < ML ? (row >> 12) : 4;
        const float* xi = row < ML ? ap->in[I_X] + (size_t)row * D : ap->in[I_CTX] + (size_t)(row - ML) * D;
        const float* sh = MOD + (size_t)r * NMODC; const float* sc = sh + D;
#pragma unroll
        for (int j = 0; j < 8; ++j) { const int c = 4 * lane + 256 * j; const f32x4 xv = *(const GAS f32x4*)(xi + c), s1 = *(const GAS f32x4*)(sh + c), s2 = *(const GAS f32x4*)(sc + c);
            const f32x4 hv = xv * (1.0f + s2) + s1; v2u w; w.x = cvt_pk_bf16(hv[0], hv[1]); w.y = cvt_pk_bf16(hv[2], hv[3]); *(GAS v2u*)(Hb + (size_t)row * D + c) = w; }
    } }
    GRID_BAR();
#endif
    ffn_block<0, 0>(args, lds, wv0); mixer_block<0>(args, lds, wv0); ffn_block<0, 1>(args, lds, wv0);
    ffn_block<1, 0>(args, lds, wv0); mixer_block<1>(args, lds, wv0); ffn_block<1, 1>(args, lds, wv0);
    { PH_BEGIN();
      if (xb_ld((unsigned*)(wsp + WS_CTL) + CW_BAR + XB_TMO) != 0u) { const float q = __builtin_nanf("");
          for (size_t i = (size_t)gtid; i < (size_t)ML * D; i += (size_t)NT) ap->out[i] = q; } }
}

#undef MODP
#undef MOD
#undef AGG
#undef XCTX
#undef SLOTP
#undef Hb
#undef Yb
#undef S0
#undef RGX
#undef GG
#undef SCB
#undef SCX
#undef SGR
#undef SGS
#undef XC
#undef ASC
#undef LAF
#undef VF
#undef LAB
#undef VB
#undef HLF
#undef HLB
#undef PF
#undef PB
#undef ARG
#undef T1
#undef MG
#undef ACT
#undef PART3
#undef PART5
#undef PARTF
#undef MODL
extern "C" void kernel_launch(void* const* d_in, const int* in_sizes, int n_in, void* d_out, int out_size, void* d_ws, size_t ws_size, hipStream_t stream) {
    static int grid = 0;
    if (grid == 0) {
        if (n_in != 23 || out_size != ML * D || ws_size < WS_END) { fprintf(stderr, "kernel_launch: unexpected shapes (n_in %d, out %d, ws %zu, need %zu); nothing launched\n", n_in, out_size, ws_size, (size_t)WS_END); grid = -1; return; }
        int dev = 0, cus = 0, per_cu = 0;
        if (hipGetDevice(&dev) != hipSuccess || hipDeviceGetAttribute(&cus, hipDeviceAttributeMultiprocessorCount, dev) != hipSuccess) { grid = -1; return; }
        if (hipFuncSetAttribute((const void*)fwd_kernel, hipFuncAttributeMaxDynamicSharedMemorySize, LDS_BYTES) != hipSuccess) { fprintf(stderr, "kernel_launch: hipFuncSetAttribute failed\n"); grid = -1; return; }
        if (hipOccupancyMaxActiveBlocksPerMultiprocessor(&per_cu, (const void*)fwd_kernel, NWAVES * 64, LDS_BYTES) != hipSuccess || per_cu < 1)
            fprintf(stderr, "kernel_launch: occupancy query reports %d workgroups per CU\n", per_cu);
        (void)hipGetLastError();
        grid = cus;
    }
    if (grid < 0) return;
    if (hipMemsetAsync((char*)d_ws + WS_CTL, 0, CTL_ZERO_BYTES, stream) != hipSuccess) return;
    Args a{};
    for (int i = 0; i < 23; ++i) a.in[i] = (const float*)d_in[i];
    a.out = (float*)d_out; a.ws = (unsigned char*)d_ws; a.grid = grid; a.pad = 0;
    hipLaunchKernelGGL(fwd_kernel, dim3(grid), dim3(NWAVES * 64), LDS_BYTES, stream, a);
    const hipError_t le = hipPeekAtLastError();
    if (le != hipSuccess) fprintf(stderr, "kernel_launch: launch failed: %s\n", hipGetErrorName(le));
}
```

```cpp
#include <hip/hip_runtime.h>
#include <cstdio>
#include <cstdint>

namespace pg8 {
#define PG8_LAS __attribute__((address_space(3)))
typedef unsigned short bf16_t;
typedef short bf16x8 __attribute__((ext_vector_type(8)));
typedef float f32x4 __attribute__((ext_vector_type(4)));
typedef unsigned u32x4 __attribute__((ext_vector_type(4)));
constexpr int BM = 256, BK = 64, HALF = 128, HTB = HALF * BK * 2, STAGE_BYTES = 8 * HTB, NXCD = 8, WGM = 8;

__host__ __device__ __forceinline__ int lds_byte(int r, int c) { const int st = (r >> 4) * 2 + (c >> 5), rr = r & 15, cc = c & 31, ob = rr * 64 + cc * 2; return st * 1024 + (ob ^ (((ob >> 9) & 1) << 5)); }
__host__ __device__ __forceinline__ void stage_rc(int b, int& R, int& C) { const int st = b / 1024, sb = b % 1024, swz = sb ^ (((sb >> 9) & 1) << 5); R = (st >> 1) * 16 + swz / 64; C = (st & 1) * 32 + (swz % 64) / 2; }
__host__ __device__ __forceinline__ int perm32(int rho) { const int n = rho >> 4, i = rho & 15; return 8 * (i >> 2) + 4 * n + (i & 3); }

struct Unit { int pm, pn; };
struct Gemm { const bf16_t* A; const bf16_t* Bt; };

template <int NN> struct SchedX {
    int G, c, nM, sh; unsigned* flag; unsigned need; mutable int tail;
    __device__ __forceinline__ void init(int G_, int c_, int nM_, int sh_, unsigned* flag_, unsigned need_) { G = G_; c = c_; nM = nM_; sh = sh_; flag = flag_; need = need_; tail = 0; }
    __device__ __forceinline__ bool next(int i, Unit& u) const {
        const int nwg = nM * NN, nfull = (nwg / G) * G;
        int L; tail = 0;
        if (i * G < nfull) L = i * G + c;
        else { if (i * G != nfull) return false; const int k = c - sh; if (k < 0 || k >= nwg - nfull) return false; L = nfull + k; tail = 1; }
        int wgid = L; { const int q = nwg / NXCD, r = nwg % NXCD; const int xcd = wgid % NXCD, off = wgid / NXCD; wgid = (xcd < r ? xcd * (q + 1) : r * (q + 1) + (xcd - r) * q) + off; }
        constexpr int nig = WGM * NN; const int gid = wgid / nig, fm = gid * WGM, gsz = (nM - fm) < WGM ? (nM - fm) : WGM;
        u.pm = fm + ((wgid % nig) % gsz); u.pn = (wgid % nig) / gsz; return true;
    }
    __device__ __forceinline__ void a_ready(const Unit&) const {
        if (flag != nullptr && tail) { unsigned sp = 0;
            while (__hip_atomic_load(flag, __ATOMIC_RELAXED, __HIP_MEMORY_SCOPE_AGENT) < need && ++sp < (1u << 22)) __builtin_amdgcn_s_sleep(2);
            __builtin_amdgcn_fence(__ATOMIC_ACQUIRE, "agent"); }
    }
    __device__ __forceinline__ void done(const Unit&) const {}
};

template <int NN> struct Sched {
    int G, c, nM;
    __device__ __forceinline__ void init(int G_, int c_, int nM_) { G = G_; c = c_; nM = nM_; }
    __device__ __forceinline__ bool next(int i, Unit& u) const {
        const int nwg = nM * NN;
        const int L = i * G + c; if (L >= nwg) return false;
        int wgid = L; { const int q = nwg / NXCD, r = nwg % NXCD; const int xcd = wgid % NXCD, off = wgid / NXCD; wgid = (xcd < r ? xcd * (q + 1) : r * (q + 1) + (xcd - r) * q) + off; }
        constexpr int nig = WGM * NN; const int gid = wgid / nig, fm = gid * WGM, gsz = (nM - fm) < WGM ? (nM - fm) : WGM;
        u.pm = fm + ((wgid % nig) % gsz); u.pn = (wgid % nig) / gsz; return true;
    }
    __device__ __forceinline__ void a_ready(const Unit&) const {}
    __device__ __forceinline__ void done(const Unit&) const {}
};

typedef float f32x2_t __attribute__((ext_vector_type(2)));
typedef __bf16 bf16x2_t __attribute__((ext_vector_type(2)));
__device__ __forceinline__ unsigned cvt_pk_bf16(float lo, float hi) { const f32x2_t v = {lo, hi}; return __builtin_bit_cast(unsigned, __builtin_convertvector(v, bf16x2_t)); }
__device__ __forceinline__ float bflo(unsigned w) { return __uint_as_float(w << 16); }
__device__ __forceinline__ float bfhi(unsigned w) { return __uint_as_float(w & 0xffff0000u); }
__device__ __forceinline__ float sigmoidf_(float x) { return __builtin_amdgcn_rcpf(1.0f + __expf(-x)); }


struct EpiPlain {
    static constexpr bool PERM = true, AFTER_DRAIN = false;
    bf16_t* O; int ldc;
    __device__ __forceinline__ void operator()(const f32x4 (&acc)[2][2][4][2], const Unit& u, int wr, int wc, int fr, int fq) const {
        const int row0 = u.pm * BM + wr * 64 + fr, col0 = u.pn * BM + wc * 32 + 8 * fq;
#pragma unroll
        for (int ai = 0; ai < 2; ++ai)
#pragma unroll
            for (int m = 0; m < 4; ++m) { bf16_t* rowp = O + (size_t)(row0 + ai * HALF + m * 16) * ldc + col0;
#pragma unroll
                for (int bj = 0; bj < 2; ++bj) { const f32x4 v0 = acc[ai][bj][m][0], v1 = acc[ai][bj][m][1];
                    u32x4 w; w.x = cvt_pk_bf16(v0[0], v0[1]); w.y = cvt_pk_bf16(v0[2], v0[3]); w.z = cvt_pk_bf16(v1[0], v1[1]); w.w = cvt_pk_bf16(v1[2], v1[3]);
                    *(u32x4*)(rowp + bj * HALF) = w; } }
    }
};
struct EpiSwiGLU {
    static constexpr bool PERM = true, AFTER_DRAIN = false;
    bf16_t* O; int ldc;
    __device__ __forceinline__ void operator()(const f32x4 (&acc)[2][2][4][2], const Unit& u, int wr, int wc, int fr, int fq) const {
        const int row0 = u.pm * BM + wr * 64 + fr, col0 = u.pn * HALF + wc * 32 + 8 * fq;
#pragma unroll
        for (int ai = 0; ai < 2; ++ai)
#pragma unroll
            for (int m = 0; m < 4; ++m) { bf16_t* rowp = O + (size_t)(row0 + ai * HALF + m * 16) * ldc + col0;
                float o[8];
#pragma unroll
                for (int n = 0; n < 2; ++n)
#pragma unroll
                    for (int j = 0; j < 4; ++j) { const float g = acc[ai][0][m][n][j], up = acc[ai][1][m][n][j]; o[n * 4 + j] = g * sigmoidf_(g) * up; }
                u32x4 w; w.x = cvt_pk_bf16(o[0], o[1]); w.y = cvt_pk_bf16(o[2], o[3]); w.z = cvt_pk_bf16(o[4], o[5]); w.w = cvt_pk_bf16(o[6], o[7]);
                *(u32x4*)rowp = w; }
    }
};
struct EpiProj {
    static constexpr bool PERM = true, AFTER_DRAIN = false;
    bf16_t* base; size_t slot; const float* bm;
    __device__ __forceinline__ void operator()(const f32x4 (&acc)[2][2][4][2], const Unit& u, int wr, int wc, int fr, int fq) const {
        const int pn = u.pn; const int row0 = u.pm * BM + wr * 64 + fr;
        if (pn >= 24 && pn < 40) {
            bf16_t* O = base + 3 * slot; const int col0 = (pn - 24) * HALF + wc * 32 + 8 * fq;
#pragma unroll
            for (int ai = 0; ai < 2; ++ai)
#pragma unroll
                for (int m = 0; m < 4; ++m) { bf16_t* rowp = O + (size_t)(row0 + ai * HALF + m * 16) * 2048 + col0;
                    const f32x4 p0 = acc[ai][0][m][0] * acc[ai][1][m][0], p1 = acc[ai][0][m][1] * acc[ai][1][m][1];
                    u32x4 w; w.x = cvt_pk_bf16(p0[0], p0[1]); w.y = cvt_pk_bf16(p0[2], p0[3]); w.z = cvt_pk_bf16(p1[0], p1[1]); w.w = cvt_pk_bf16(p1[2], p1[3]);
                    *(u32x4*)rowp = w; }
        } else {
            int sec, tl; if (pn < 24) { sec = pn >> 3; tl = pn & 7; } else { sec = 4 + ((pn - 40) >> 3); tl = (pn - 40) & 7; }
            bf16_t* O = base + (size_t)sec * slot; const int col0 = tl * BM + wc * 32 + 8 * fq;
            if (sec == 0 || sec == 2) {
#pragma unroll
                for (int ai = 0; ai < 2; ++ai)
#pragma unroll
                    for (int m = 0; m < 4; ++m) { bf16_t* rowp = O + (size_t)(row0 + ai * HALF + m * 16) * 2048 + col0;
#pragma unroll
                        for (int bj = 0; bj < 2; ++bj) { const f32x4 v0 = acc[ai][bj][m][0], v1 = acc[ai][bj][m][1];
                            u32x4 w; w.x = cvt_pk_bf16(v0[0], v0[1]); w.y = cvt_pk_bf16(v0[2], v0[3]); w.z = cvt_pk_bf16(v1[0], v1[1]); w.w = cvt_pk_bf16(v1[2], v1[3]);
                            *(u32x4*)(rowp + bj * HALF) = w; } }
            } else if (sec == 1) {
#pragma unroll
                for (int ai = 0; ai < 2; ++ai)
#pragma unroll
                    for (int m = 0; m < 4; ++m) { bf16_t* rowp = O + (size_t)(row0 + ai * HALF + m * 16) * 2048 + col0;
#pragma unroll
                        for (int bj = 0; bj < 2; ++bj) { float o[8];
#pragma unroll
                            for (int n = 0; n < 2; ++n)
#pragma unroll
                                for (int j = 0; j < 4; ++j) { const float x = acc[ai][bj][m][n][j]; o[n * 4 + j] = x * sigmoidf_(1.5957691216f * (x + 0.044715f * x * x * x)); }
                            u32x4 w; w.x = cvt_pk_bf16(o[0], o[1]); w.y = cvt_pk_bf16(o[2], o[3]); w.z = cvt_pk_bf16(o[4], o[5]); w.w = cvt_pk_bf16(o[6], o[7]);
                            *(u32x4*)(rowp + bj * HALF) = w; } }
            } else {
                const float* bb = bm + (sec - 4) * 2048 + col0;
                f32x4 bv[2][2];
#pragma unroll
                for (int bj = 0; bj < 2; ++bj)
#pragma unroll
                    for (int n = 0; n < 2; ++n) bv[bj][n] = *(const f32x4*)(bb + bj * HALF + 4 * n);
#pragma unroll
                for (int ai = 0; ai < 2; ++ai)
#pragma unroll
                    for (int m = 0; m < 4; ++m) { bf16_t* rowp = O + (size_t)(row0 + ai * HALF + m * 16) * 2048 + col0;
#pragma unroll
                        for (int bj = 0; bj < 2; ++bj) { float o[8];
#pragma unroll
                            for (int n = 0; n < 2; ++n)
#pragma unroll
                                for (int j = 0; j < 4; ++j) o[n * 4 + j] = sigmoidf_(acc[ai][bj][m][n][j] + bv[bj][n][j]);
                            u32x4 w; w.x = cvt_pk_bf16(o[0], o[1]); w.y = cvt_pk_bf16(o[2], o[3]); w.z = cvt_pk_bf16(o[4], o[5]); w.w = cvt_pk_bf16(o[6], o[7]);
                            *(u32x4*)(rowp + bj * HALF) = w; } }
            }
        }
    }
};
struct EpiGate {
    static constexpr bool PERM = true, AFTER_DRAIN = false;
    const bf16_t* XC; bf16_t* LA0; bf16_t* V0; bf16_t* LA1; bf16_t* V1;
    const float* gb;
    const float* ls8t;
    __device__ __forceinline__ void operator()(const f32x4 (&acc)[2][2][4][2], const Unit& u, int wr, int wc, int fr, int fq) const {
        const int pn = u.pn, hd = pn >> 1, d = pn & 1;
        const int row0 = u.pm * BM + wr * 64 + fr, ch0 = hd * HALF + wc * 32 + 8 * fq;
        bf16_t* LA = d ? LA1 : LA0; bf16_t* V = d ? V1 : V0;
        const float* pbr = gb + (size_t)(d * 2 + 0) * 2048 + ch0; const float* pbi = gb + (size_t)(d * 2 + 1) * 2048 + ch0; const float* pls = ls8t + (size_t)d * 2048 + ch0;
        f32x4 br[2], bi[2], ls8[2];
#pragma unroll
        for (int n = 0; n < 2; ++n) { br[n] = *(const f32x4*)(pbr + 4 * n); bi[n] = *(const f32x4*)(pbi + 4 * n); ls8[n] = *(const f32x4*)(pls + 4 * n); }
#pragma unroll
        for (int ai = 0; ai < 2; ++ai) {
#pragma unroll
          for (int mh = 0; mh < 4; mh += 2) {
            u32x4 xw[4];
#pragma unroll
            for (int m = mh; m < mh + 2; ++m) xw[m] = *(const u32x4*)(XC + (size_t)(row0 + ai * HALF + m * 16) * 2048 + ch0);
#pragma unroll
            for (int m = mh; m < mh + 2; ++m) { const size_t off = (size_t)(row0 + ai * HALF + m * 16) * 2048 + ch0;
                const float uu[8] = {bflo(xw[m].x), bfhi(xw[m].x), bflo(xw[m].y), bfhi(xw[m].y), bflo(xw[m].z), bfhi(xw[m].z), bflo(xw[m].w), bfhi(xw[m].w)};
                float la[8], vv[8];
#pragma unroll
                for (int n = 0; n < 2; ++n)
#pragma unroll
                    for (int j = 0; j < 4; ++j) { const int k = n * 4 + j;
                        const float r = sigmoidf_(acc[ai][0][m][n][j] + br[n][j]), ig = sigmoidf_(acc[ai][1][m][n][j] + bi[n][j]);
                        const float l1 = ls8[n][j] * r, z = 2.0f * l1;
                        const float em = z > -0.02f ? -z * (1.0f + z * (0.5f + z * (0.16666667f + z * 0.041666667f))) : 1.0f - __expf(z);
                        la[k] = l1; vv[k] = __builtin_sqrtf(em) * ig * uu[k]; }
                u32x4 w; w.x = cvt_pk_bf16(la[0], la[1]); w.y = cvt_pk_bf16(la[2], la[3]); w.z = cvt_pk_bf16(la[4], la[5]); w.w = cvt_pk_bf16(la[6], la[7]);
                *(u32x4*)(LA + off) = w;
                w.x = cvt_pk_bf16(vv[0], vv[1]); w.y = cvt_pk_bf16(vv[2], vv[3]); w.z = cvt_pk_bf16(vv[4], vv[5]); w.w = cvt_pk_bf16(vv[6], vv[7]);
                *(u32x4*)(V + off) = w; }
            asm volatile("" ::: "memory"); } }
    }
};
template <bool ADD> struct EpiGated {
    static constexpr bool PERM = true, AFTER_DRAIN = false;
    bf16_t* O; const bf16_t* G; const bf16_t* T; const float* TP; int ctx0;
    __device__ __forceinline__ void operator()(const f32x4 (&acc)[2][2][4][2], const Unit& u, int wr, int wc, int fr, int fq) const {
        const int row0 = u.pm * BM + wr * 64 + fr, col0 = u.pn * BM + wc * 32 + 8 * fq;
        const bool part = ADD && TP != nullptr && u.pm * BM >= ctx0;
        const __amdgpu_buffer_rsrc_t rTP = __builtin_amdgcn_make_buffer_rsrc((void*)TP, 0, 4 * 1024 * 2048 * 4, 0x00020000);
        const int vo = ((row0 - ctx0) * 2048 + col0) * 4;
#pragma unroll
        for (int ai = 0; ai < 2; ++ai) {
            u32x4 gwv[4][2], twv[4][2];
#pragma unroll
            for (int m = 0; m < 4; ++m)
#pragma unroll
                for (int bj = 0; bj < 2; ++bj) { const size_t off = (size_t)(row0 + ai * HALF + m * 16) * 2048 + col0;
                    gwv[m][bj] = *(const u32x4*)(G + off + bj * HALF);
                    if (ADD && !part) twv[m][bj] = *(const u32x4*)(T + off + bj * HALF); }
#pragma unroll
            for (int m = 0; m < 4; ++m) { const size_t off = (size_t)(row0 + ai * HALF + m * 16) * 2048 + col0;
#pragma unroll
                for (int bj = 0; bj < 2; ++bj) { const u32x4 gw = gwv[m][bj];
                    float o[8] = {bflo(gw.x) * acc[ai][bj][m][0][0], bfhi(gw.x) * acc[ai][bj][m][0][1], bflo(gw.y) * acc[ai][bj][m][0][2], bfhi(gw.y) * acc[ai][bj][m][0][3],
                                  bflo(gw.z) * acc[ai][bj][m][1][0], bfhi(gw.z) * acc[ai][bj][m][1][1], bflo(gw.w) * acc[ai][bj][m][1][2], bfhi(gw.w) * acc[ai][bj][m][1][3]};
                    if (ADD) {
                        if (part) {
#pragma unroll
                            for (int ks = 0; ks < 4; ++ks) { const int so = (ks * 1024 * 2048 + (ai * HALF + m * 16) * 2048 + bj * HALF) * 4;
                                const f32x4 a = __builtin_bit_cast(f32x4, __builtin_amdgcn_raw_buffer_load_b128(rTP, vo, so, 0)), b = __builtin_bit_cast(f32x4, __builtin_amdgcn_raw_buffer_load_b128(rTP, vo, so + 16, 0));
                                o[0] += a[0]; o[1] += a[1]; o[2] += a[2]; o[3] += a[3]; o[4] += b[0]; o[5] += b[1]; o[6] += b[2]; o[7] += b[3]; } }
                        else { const u32x4 tw = twv[m][bj];
                            o[0] += bflo(tw.x); o[1] += bfhi(tw.x); o[2] += bflo(tw.y); o[3] += bfhi(tw.y); o[4] += bflo(tw.z); o[5] += bfhi(tw.z); o[6] += bflo(tw.w); o[7] += bfhi(tw.w); } }
                    u32x4 w; w.x = cvt_pk_bf16(o[0], o[1]); w.y = cvt_pk_bf16(o[2], o[3]); w.z = cvt_pk_bf16(o[4], o[5]); w.w = cvt_pk_bf16(o[6], o[7]);
                    *(u32x4*)(O + off + bj * HALF) = w; } }
        }
    }
};
template <bool HASG> struct EpiPartial {
    static constexpr bool PERM = true, AFTER_DRAIN = false;
    float* P; const bf16_t* G;
    int grow0;
    __device__ __forceinline__ void operator()(const f32x4 (&acc)[2][2][4][2], const Unit& u, int wr, int wc, int fr, int fq) const {
        const int ks = u.pn >> 3, ct = u.pn & 7;
        const int row0 = u.pm * BM + wr * 64 + fr, col0 = ct * BM + wc * 32 + 8 * fq;
        const __amdgpu_buffer_rsrc_t rP = __builtin_amdgcn_make_buffer_rsrc((void*)(P + (size_t)ks * 1024 * 2048), 0, 1024 * 2048 * 4, 0x00020000);
        const __amdgpu_buffer_rsrc_t rG = __builtin_amdgcn_make_buffer_rsrc((void*)(HASG ? G + (size_t)grow0 * 2048 : (const bf16_t*)P), 0, 1024 * 2048 * 2, 0x00020000);
        const int vo = (row0 * 2048 + col0) * 4, vg = (row0 * 2048 + col0) * 2;
#pragma unroll
        for (int ai = 0; ai < 2; ++ai)
#pragma unroll
            for (int m = 0; m < 4; ++m)
#pragma unroll
                for (int bj = 0; bj < 2; ++bj) { f32x4 v0 = acc[ai][bj][m][0], v1 = acc[ai][bj][m][1]; const int so = ((ai * HALF + m * 16) * 2048 + bj * HALF);
                    if constexpr (HASG) { const u32x4 gw = __builtin_amdgcn_raw_buffer_load_b128(rG, vg, so * 2, 0);
                        v0 = v0 * (f32x4){bflo(gw.x), bfhi(gw.x), bflo(gw.y), bfhi(gw.y)}; v1 = v1 * (f32x4){bflo(gw.z), bfhi(gw.z), bflo(gw.w), bfhi(gw.w)}; }
                    __builtin_amdgcn_raw_buffer_store_b128(__builtin_bit_cast(u32x4, v0), rP, vo, so * 4, 0); __builtin_amdgcn_raw_buffer_store_b128(__builtin_bit_cast(u32x4, v1), rP, vo, so * 4 + 16, 0); }
    }
};

template <class Epi, bool ALIGN_EPI, int LDA, int LDB, int KD, int KDIV, int KSTR, int BMOD, class SchedT>
__device__ __forceinline__ void gemm_phase(PG8_LAS unsigned char* lds, const Gemm g, const SchedT& S, const Epi& E, const int tid) {
    const int wid = __builtin_amdgcn_readfirstlane(tid >> 6), lane = tid & 63, wr = wid >> 2, wc = wid & 3, fr = lane & 15, fq = lane >> 4;
    constexpr int nt = KD / BK;
    unsigned voffA[2], voffB[2];
#pragma unroll
    for (int i = 0; i < 2; ++i) { int R, C; stage_rc(tid * 16 + i * 8192, R, C); const int Rb = Epi::PERM ? ((R & ~31) + perm32(R & 31)) : R;
        voffA[i] = (unsigned)(R * LDA + C) * 2u; voffB[i] = (unsigned)(Rb * LDB + C) * 2u; }
    constexpr size_t kstep = (size_t)(BK * 2);
    constexpr size_t hstepA = (size_t)HALF * LDA * 2, hstepB = (size_t)HALF * LDB * 2;
    const unsigned ldsw = (unsigned)wid * 1024u;
    const int aoff = lds_byte(wr * 64 + fr, fq * 8), boff = lds_byte(wc * 32 + fr, fq * 8);
#define PG8_SA(b, h) (((b) * 2 + (h)) * HTB)
#define PG8_SB(b, h) ((4 + (b) * 2 + (h)) * HTB)
#define PG8_STAGE(bufoff, gbase, voff) do { _Pragma("unroll") for (int _i = 0; _i < 2; ++_i) \
        __builtin_amdgcn_global_load_lds((const unsigned*)((const char*)(gbase) + (voff)[_i]), (PG8_LAS unsigned*)(lds + (bufoff) + ldsw + _i * 8192), 16, 0, 0); } while (0)
#define PG8_LDA(dst, b, h) do { _Pragma("unroll") for (int m = 0; m < 4; ++m) _Pragma("unroll") for (int k = 0; k < 2; ++k) dst[m][k] = *(const PG8_LAS bf16x8*)(lds + PG8_SA(b, h) + aoff + m * 2048 + k * 1024); } while (0)
#define PG8_LDB(dst, b, h) do { _Pragma("unroll") for (int n = 0; n < 2; ++n) _Pragma("unroll") for (int k = 0; k < 2; ++k) dst[n][k] = *(const PG8_LAS bf16x8*)(lds + PG8_SB(b, h) + boff + n * 2048 + k * 1024); } while (0)
#define PG8_MMA(ai, bj, At, Bt) do { __builtin_amdgcn_s_setprio(1); _Pragma("unroll") for (int m = 0; m < 4; ++m) _Pragma("unroll") for (int n = 0; n < 2; ++n) _Pragma("unroll") for (int k = 0; k < 2; ++k) \
        acc[ai][bj][m][n] = __builtin_amdgcn_mfma_f32_16x16x32_bf16(Bt[n][k], At[m][k], acc[ai][bj][m][n], 0, 0, 0); __builtin_amdgcn_s_setprio(0); } while (0)
#define PG8_WAIT_V(n) asm volatile("s_waitcnt vmcnt(" #n ")" ::: "memory")
#define PG8_WAIT_L(n) asm volatile("s_waitcnt lgkmcnt(" #n ")" ::: "memory")
#define PG8_BAR __builtin_amdgcn_s_barrier()
#define PG8_SCHED __builtin_amdgcn_sched_barrier(0)
#define PG8_APTR(u) ((const char*)g.A + ((size_t)(u).pm * BM * LDA + (size_t)(KDIV ? ((u).pn / (KDIV ? KDIV : 1)) * KSTR : 0)) * 2)
#define PG8_BPTR(u) ((const char*)g.Bt + ((size_t)(BMOD ? (u).pn % (BMOD ? BMOD : 1) : (u).pn) * BM * LDB + (size_t)(BMOD ? ((u).pn / (BMOD ? BMOD : 1)) * KSTR : 0)) * 2)
    Unit cur, nxt; int ui = 0;
    if (!S.next(0, cur)) return;
    f32x4 acc[2][2][4][2];
#pragma unroll
    for (int a = 0; a < 2; ++a)
#pragma unroll
        for (int b = 0; b < 2; ++b)
#pragma unroll
            for (int m = 0; m < 4; ++m)
#pragma unroll
                for (int n = 0; n < 2; ++n) acc[a][b][m][n] = (f32x4){0.f, 0.f, 0.f, 0.f};
    bf16x8 At[4][2], B0[2][2], B1[2][2];
    const char* cA = PG8_APTR(cur); const char* cB = PG8_BPTR(cur);
    S.a_ready(cur);
    PG8_STAGE(PG8_SB(0, 0), cB, voffB); PG8_STAGE(PG8_SB(0, 1), cB + hstepB, voffB); PG8_STAGE(PG8_SA(0, 0), cA, voffA); PG8_STAGE(PG8_SA(0, 1), cA + hstepA, voffA);
    if (wr == 1) PG8_BAR;
    PG8_WAIT_V(2); PG8_BAR;
    PG8_STAGE(PG8_SB(1, 0), cB + kstep, voffB); PG8_STAGE(PG8_SA(1, 0), cA + kstep, voffA); PG8_STAGE(PG8_SB(1, 1), cB + hstepB + kstep, voffB);
    PG8_WAIT_V(6); PG8_BAR;
    for (;;) {
        const bool has_next = S.next(ui + 1, nxt);
        const char* nA = has_next ? PG8_APTR(nxt) : cA; const char* nB = has_next ? PG8_BPTR(nxt) : cB;
        for (int t = 0; t < nt; t += 2) {
            const bool last = (t == nt - 2);
            const char* a1 = cA + (size_t)(t + 1) * kstep;
            const char* a2 = last ? nA : cA + (size_t)(t + 2) * kstep; const char* b2 = last ? nB : cB + (size_t)(t + 2) * kstep;
            const char* a3 = a2 + kstep; const char* b3 = b2 + kstep;
            if (last && has_next) S.a_ready(nxt);
            PG8_LDB(B0, 0, 0); PG8_LDB(B1, 0, 1); PG8_SCHED; PG8_LDA(At, 0, 0); PG8_STAGE(PG8_SA(1, 1), a1 + hstepA, voffA);
            PG8_WAIT_V(8); PG8_WAIT_L(0); PG8_BAR; PG8_MMA(0, 0, At, B0); PG8_MMA(0, 1, At, B1); PG8_BAR; PG8_SCHED;
            PG8_LDA(At, 0, 1); PG8_STAGE(PG8_SB(0, 0), b2, voffB); PG8_STAGE(PG8_SB(0, 1), b2 + hstepB, voffB); PG8_STAGE(PG8_SA(0, 0), a2, voffA);
            PG8_WAIT_V(8); PG8_WAIT_L(0); PG8_BAR; PG8_MMA(1, 0, At, B0); PG8_MMA(1, 1, At, B1); PG8_BAR; PG8_SCHED;
            PG8_LDB(B0, 1, 0); PG8_LDB(B1, 1, 1); PG8_SCHED; PG8_LDA(At, 1, 0); PG8_STAGE(PG8_SA(0, 1), a2 + hstepA, voffA);
            PG8_WAIT_V(8); PG8_WAIT_L(0); PG8_BAR; PG8_MMA(0, 0, At, B0); PG8_MMA(0, 1, At, B1); PG8_BAR; PG8_SCHED;
            PG8_LDA(At, 1, 1); PG8_STAGE(PG8_SB(1, 0), b3, voffB); PG8_STAGE(PG8_SB(1, 1), b3 + hstepB, voffB); PG8_STAGE(PG8_SA(1, 0), a3, voffA);
            PG8_WAIT_V(8); PG8_WAIT_L(0); PG8_BAR; PG8_MMA(1, 0, At, B0); PG8_MMA(1, 1, At, B1); PG8_BAR; PG8_SCHED;
        }
        if constexpr (ALIGN_EPI) { if (wr == 0) PG8_BAR; }
        E(acc, cur, wr, wc, fr, fq); S.done(cur);
        if (!has_next) break;
#pragma unroll
        for (int a = 0; a < 2; ++a)
#pragma unroll
            for (int b = 0; b < 2; ++b)
#pragma unroll
                for (int m = 0; m < 4; ++m)
#pragma unroll
                    for (int n = 0; n < 2; ++n) acc[a][b][m][n] = (f32x4){0.f, 0.f, 0.f, 0.f};
        cur = nxt; cA = nA; cB = nB; ++ui;
        if constexpr (ALIGN_EPI) { if (wr == 1) PG8_BAR; }
    }
    PG8_WAIT_V(0);
    if constexpr (!ALIGN_EPI) { if (wr == 0) PG8_BAR; }
    PG8_BAR;
#undef PG8_SA
#undef PG8_SB
#undef PG8_STAGE
#undef PG8_LDA
#undef PG8_LDB
#undef PG8_MMA
#undef PG8_WAIT_V
#undef PG8_WAIT_L
#undef PG8_BAR
#undef PG8_SCHED
#undef PG8_APTR
#undef PG8_BPTR
}
}

constexpr int NWAVES = 8;
constexpr int D = 2048, BATCH = 4, SEQ = 4096, CTXL = 256, DFF = 5632, DEPTH = 2;
constexpr int ML = BATCH * SEQ, MC = BATCH * CTXL, M = ML + MC, NPAN = M / 256;
constexpr int PROJ_W = 14336, NMODC = 9 * D;
constexpr float LN_EPS = 1e-5f, ALPHA = 1.41421356237f;
static_assert(M % 256 == 0 && NPAN == 68, "row panels");

constexpr size_t MiB = 1u << 20;
constexpr size_t WS_CTL = 0, CTL_ZERO_BYTES = 32 * 1024;
constexpr size_t WS_MODP = 1 * MiB;
constexpr size_t WS_MOD = 7 * MiB;
constexpr size_t WS_AGG = 8 * MiB;
constexpr size_t WS_LS8 = 8 * MiB + 2560 * 1024;
constexpr size_t WS_XCTX = 11 * MiB;
constexpr size_t WS_W = 20 * MiB;
constexpr size_t W_1IN = WS_W, W_1OUT = W_1IN + 44 * MiB, W_2IN = W_1OUT + 22 * MiB, W_2OUT = W_2IN + 44 * MiB, W_IN = W_2OUT + 22 * MiB,
                 W_RG = W_IN + 56 * MiB, W_SC = W_RG + 8 * MiB, W_O = W_SC + 8 * MiB, W_G2 = W_O + 8 * MiB, W_END = W_G2 + 4 * MiB;
constexpr size_t SLOT = 68 * MiB;
constexpr size_t SLOT_ELEMS = SLOT / 2;
constexpr size_t WS_H = 236 * MiB, WS_Y = WS_H + SLOT, WS_S0 = WS_Y + SLOT, W_2OUT_ALT = WS_S0 + 10 * SLOT, WS_XHI = W_2OUT_ALT + 22 * MiB, WS_XLO = WS_XHI + 68 * MiB, WS_END = WS_XLO + 34 * MiB;
static_assert(W_END <= WS_H && (size_t)M * D * 2 == SLOT && (size_t)M * DFF * 2 <= 3 * SLOT, "d_ws map");
constexpr int CW_BAR = 4096;

constexpr int RING_OFF = 0, RING_BYTES = 131072;
constexpr int LDS_BYTES = 147456;
constexpr int LDSCTL_OFF = LDS_BYTES - 1024, MISC_OFF = LDSCTL_OFF + 320;

#define GAS __attribute__((address_space(1)))
#define LAS __attribute__((address_space(3)))
typedef unsigned short bf16;
typedef unsigned v4u __attribute__((ext_vector_type(4)));
typedef unsigned v2u __attribute__((ext_vector_type(2)));
typedef float f32x4 __attribute__((ext_vector_type(4)));
#define LDS_WAIT() asm volatile("s_waitcnt lgkmcnt(0)" ::: "memory")
using pg8::cvt_pk_bf16; using pg8::bflo; using pg8::bfhi;

#define XB_TMO      128
#define XB_XCNT(j)  (256  + 64 * (j))
#define XB_XSUB(j)  (1280 + 64 * (j))
#define XB_XGEN(j)  (2304 + 64 * (j))
#define XB_TOP      3328
#define XB_TOPGEN   3392
#define XCD_BAR_WORDS 3456
#define XB_SPIN_CAP (1u << 18)
__device__ __forceinline__ unsigned xb_ld(unsigned* p)              { return __hip_atomic_load(p, __ATOMIC_RELAXED, __HIP_MEMORY_SCOPE_AGENT); }
__device__ __forceinline__ unsigned xb_add(unsigned* p, unsigned v) { return __hip_atomic_fetch_add(p, v, __ATOMIC_RELAXED, __HIP_MEMORY_SCOPE_AGENT); }
__device__ __forceinline__ unsigned xb_xcc_id() { return (unsigned)__builtin_amdgcn_s_getreg((3 << 11) | 20) & 0xFu; }
#define XB_SPIN(cond, bar) do { unsigned _sp = 0; while (cond) { __builtin_amdgcn_s_sleep(1); \
    if ((++_sp & 255u) == 0u) { if (xb_ld(&(bar)[XB_TMO])) break; if (_sp > XB_SPIN_CAP) { atomicAdd(&(bar)[XB_TMO], 1u); break; } } } } while (0)
struct XcdBarrier { unsigned* bar; unsigned x; volatile LAS unsigned* st; unsigned G; };
__device__ __forceinline__ XcdBarrier xcd_barrier_post(unsigned* bar, volatile LAS unsigned* st) {
    XcdBarrier b; b.bar = bar; b.x = xb_xcc_id(); b.st = st; b.G = 0u;
    if (threadIdx.x == 0) (void)xb_add(&bar[XB_XCNT(b.x)], 1u);
    return b;
}
__device__ __forceinline__ void xcd_barrier_complete(unsigned* bar, unsigned x, unsigned& nloc, unsigned& nx, const unsigned G) {
    unsigned sum, cnt, mine, sp = 0u;
    for (;;) {
        sum = 0u; cnt = 0u; mine = 0u;
#pragma unroll
        for (unsigned j = 0; j < 16; ++j) { const unsigned c = xb_ld(&bar[XB_XCNT(j)]); sum += c; cnt += (c > 0u) ? 1u : 0u; mine = (j == x) ? c : mine; }
        if (sum == G) break;
        __builtin_amdgcn_s_sleep(1);
        if ((++sp & 255u) == 0u) { if (xb_ld(&bar[XB_TMO])) break; if (sp > XB_SPIN_CAP) { atomicAdd(&bar[XB_TMO], 1u); break; } }
    }
    nloc = mine > 0u ? mine : 1u; nx = cnt > 0u ? cnt : 1u;
}
__device__ __forceinline__ void xcd_barrier(const XcdBarrier& b, const bool is_t0) {
    asm volatile("s_waitcnt vmcnt(0)" ::: "memory");
    __syncthreads();
    if (is_t0) {
        unsigned* bar = b.bar;
        __builtin_amdgcn_s_waitcnt(0);
        unsigned nloc = b.st[0], nx = b.st[1];
        if (nloc == 0u) { xcd_barrier_complete(bar, b.x, nloc, nx, b.G); b.st[0] = nloc; b.st[1] = nx; }
        const unsigned old = xb_add(&bar[XB_XSUB(b.x)], 1u);
        const unsigned gen = old / nloc;
        if (old + 1u == (gen + 1u) * nloc) {
            __builtin_amdgcn_fence(__ATOMIC_RELEASE, "agent");
            asm volatile("s_waitcnt vmcnt(0)" ::: "memory");
            const unsigned og = xb_add(&bar[XB_TOP], 1u);
            const unsigned tg = og / nx;
            if (og + 1u == (tg + 1u) * nx) xb_add(&bar[XB_TOPGEN], 1u);
            else XB_SPIN(xb_ld(&bar[XB_TOPGEN]) == tg, bar);
            __builtin_amdgcn_fence(__ATOMIC_ACQUIRE, "agent");
            xb_add(&bar[XB_XGEN(b.x)], 1u);
            asm volatile("s_waitcnt vmcnt(0)" ::: "memory");
        } else {
            XB_SPIN(xb_ld(&bar[XB_XGEN(b.x)]) == gen, bar);
            __builtin_amdgcn_fence(__ATOMIC_ACQUIRE, "agent");
            asm volatile("s_waitcnt vmcnt(0)" ::: "memory");
        }
    }
    __syncthreads();
}

__device__ __forceinline__ float wave_sum(float v, int lane) {
#pragma unroll
    for (int o = 1; o < 64; o <<= 1) v += __builtin_bit_cast(float, __builtin_amdgcn_ds_bpermute((lane ^ o) << 2, __builtin_bit_cast(int, v)));
    return v;
}
__device__ __forceinline__ void transpose_item(const float* __restrict__ W, int N, int k0, int n0, bf16* dst, int ldd, LAS float* scr, int lane) {
    float wv[32];
#pragma unroll
    for (int i = 0; i < 32; ++i) { const int kk = 2 * i + (lane >> 5); wv[i] = W[(size_t)(k0 + kk) * N + n0 + (lane & 31)]; }
#pragma unroll
    for (int i = 0; i < 32; ++i) { const int kk = 2 * i + (lane >> 5); scr[kk * 33 + (lane & 31)] = wv[i]; }
    LDS_WAIT(); asm volatile("" ::: "memory");
    const int c = lane & 7;
#pragma unroll
    for (int j = 0; j < 4; ++j) { const int n = (lane >> 3) + 8 * j; const LAS float* s = scr + (8 * c) * 33 + n;
        v4u o; o.x = cvt_pk_bf16(s[0 * 33], s[1 * 33]); o.y = cvt_pk_bf16(s[2 * 33], s[3 * 33]); o.z = cvt_pk_bf16(s[4 * 33], s[5 * 33]); o.w = cvt_pk_bf16(s[6 * 33], s[7 * 33]);
        *(GAS v4u*)(dst + (size_t)n * ldd + 8 * c) = o; }
    LDS_WAIT(); asm volatile("" ::: "memory");
}
__device__ __forceinline__ int map_ffn_in(int n) { return n < DFF ? (n >> 7) * 256 + (n & 127) : ((n - DFF) >> 7) * 256 + 128 + ((n - DFF) & 127); }
__device__ __forceinline__ int map_proj(int n) {
    if (n < 6144 || n >= 10240) return n;
    if (n < 8192) return 6144 + ((n - 6144) >> 7) * 256 + ((n - 6144) & 127);
    return 6144 + ((n - 8192) >> 7) * 256 + 128 + ((n - 8192) & 127);
}

struct Args { const float* in[23]; float* out; unsigned char* ws; int grid; int pad; };
enum { I_X = 0, I_C, I_CTX, I_CCTX, I_WMOD, I_BMOD, I_LNG, I_LNB, I_F1IN, I_F1OUT, I_F2IN, I_F2OUT, I_WIN, I_RGCW, I_RGCB, I_RGGW, I_RGGB, I_RGLAM, I_SCCW, I_WRGO, I_WSCO, I_BMERGE, I_WO };

constexpr int CV_IN = (D / 64) * (2 * DFF / 32), CV_OUT = (DFF / 64) * (D / 32), CV_PR = (D / 64) * (PROJ_W / 32), CV_SQ = (D / 64) * (D / 32), CV_GT = 64 * 8;
constexpr int CV_UP = (CV_IN * 3) / 4;
constexpr int CV_FIRST = CV_IN + CV_OUT;
constexpr int CV_ALL = 2 * CV_IN + 2 * CV_OUT + CV_PR + 3 * CV_SQ + CV_GT;
__device__ __forceinline__ void convert_weights(const Args& a, int l, int lo, int hi, int alt2, unsigned char* ws, LAS unsigned char* lds, int wi, int NW, int wave, int lane) {
    LAS float* scr = (LAS float*)(lds + wave * 8448);
    for (int it = lo + wi; it < hi; it += NW) {
        int r = it;
        if (r < CV_IN) { const int nblk = 2 * DFF / 32, kb = r / nblk, nb = r % nblk;
            transpose_item(a.in[I_F1IN] + (size_t)l * D * 2 * DFF, 2 * DFF, kb * 64, nb * 32, (bf16*)(ws + W_1IN) + (size_t)map_ffn_in(nb * 32) * D + kb * 64, D, scr, lane); continue; }
        r -= CV_IN;
        if (r < CV_OUT) { const int nblk = D / 32, kb = r / nblk, nb = r % nblk;
            transpose_item(a.in[I_F1OUT] + (size_t)l * DFF * D, D, kb * 64, nb * 32, (bf16*)(ws + W_1OUT) + (size_t)(nb * 32) * DFF + kb * 64, DFF, scr, lane); continue; }
        r -= CV_OUT;
        if (r < CV_IN) { const int nblk = 2 * DFF / 32, kb = r / nblk, nb = r % nblk;
            transpose_item(a.in[I_F2IN] + (size_t)l * D * 2 * DFF, 2 * DFF, kb * 64, nb * 32, (bf16*)(ws + W_2IN) + (size_t)map_ffn_in(nb * 32) * D + kb * 64, D, scr, lane); continue; }
        r -= CV_IN;
        if (r < CV_OUT) { const int nblk = D / 32, kb = r / nblk, nb = r % nblk;
            transpose_item(a.in[I_F2OUT] + (size_t)l * DFF * D, D, kb * 64, nb * 32, (bf16*)(ws + (alt2 ? W_2OUT_ALT : W_2OUT)) + (size_t)(nb * 32) * DFF + kb * 64, DFF, scr, lane); continue; }
        r -= CV_OUT;
        if (r < CV_PR) { const int nblk = PROJ_W / 32, kb = r / nblk, nb = r % nblk;
            transpose_item(a.in[I_WIN] + (size_t)l * D * PROJ_W, PROJ_W, kb * 64, nb * 32, (bf16*)(ws + W_IN) + (size_t)map_proj(nb * 32) * D + kb * 64, D, scr, lane); continue; }
        r -= CV_PR;
        if (r < 3 * CV_SQ) { const int w = r / CV_SQ; r -= w * CV_SQ; const int nblk = D / 32, kb = r / nblk, nb = r % nblk;
            const float* W = (w == 0 ? a.in[I_WRGO] : (w == 1 ? a.in[I_WSCO] : a.in[I_WO])) + (size_t)l * D * D; bf16* WT = (bf16*)(ws + (w == 0 ? W_RG : (w == 1 ? W_SC : W_O)));
            transpose_item(W, D, kb * 64, nb * 32, WT + (size_t)(nb * 32) * D + kb * 64, D, scr, lane); continue; }
        r -= 3 * CV_SQ;
        {
            const int blk = r >> 3, sub = r & 7, kb = sub >> 2, nb = sub & 3, h = blk & 15, g = (blk >> 4) & 1, d = blk >> 5;
            const float* W = a.in[I_RGGW] + ((size_t)l * 64 + blk) * 16384; bf16* WT = (bf16*)(ws + W_G2);
            const int tn = h * 2 + d;
            transpose_item(W, 128, kb * 64, nb * 32, WT + (size_t)(tn * 256 + g * 128 + nb * 32) * 128 + kb * 64, 128, scr, lane); }
    }
}

template <bool IN3, bool OUT3>
__device__ __forceinline__ void ln_phase(const float* xin_lat, const float* xin_ctx, float* xout_lat, float* xout_ctx, unsigned short* XH, unsigned char* XL, const bf16* Y, const float* gate, float s,
                                         const float* lng, const float* lnb, const float* nsh, const float* nsc, bf16* H, int gw, int NGW, int lane, int nrows, const float* part) {
    if (part) {
        const __amdgpu_buffer_rsrc_t rPT = __builtin_amdgcn_make_buffer_rsrc((void*)part, 0, 4 * MC * D * 4, 0x00020000);
        for (int row = ML + gw; row < nrows; row += NGW) { const int vo = ((row - ML) * D + 4 * lane) * 4;
#pragma unroll
            for (int j = 0; j < 8; ++j) {
                const f32x4 y = (__builtin_bit_cast(f32x4, __builtin_amdgcn_raw_buffer_load_b128(rPT, vo, (256 * j) * 4, 0)) + __builtin_bit_cast(f32x4, __builtin_amdgcn_raw_buffer_load_b128(rPT, vo, (MC * D + 256 * j) * 4, 0)))
                              + (__builtin_bit_cast(f32x4, __builtin_amdgcn_raw_buffer_load_b128(rPT, vo, (2 * MC * D + 256 * j) * 4, 0)) + __builtin_bit_cast(f32x4, __builtin_amdgcn_raw_buffer_load_b128(rPT, vo, (3 * MC * D + 256 * j) * 4, 0)));
                v2u w; w.x = cvt_pk_bf16(y[0], y[1]); w.y = cvt_pk_bf16(y[2], y[3]); *(GAS v2u*)((bf16*)Y + (size_t)row * D + 4 * lane + 256 * j) = w; } }
        asm volatile("s_waitcnt vmcnt(0)" ::: "memory");
    }
#define LN_C(j) (8 * lane + 512 * ((j) >> 1) + 4 * ((j) & 1))
#define LN_DEC(hx, hy, l) (f32x4){__uint_as_float(((hx) << 16) | (((l) << 8) & 0xff00u) | 0x80u), __uint_as_float(((hx) & 0xffff0000u) | ((l) & 0xff00u) | 0x80u), \
                                  __uint_as_float(((hy) << 16) | (((l) >> 8) & 0xff00u) | 0x80u), __uint_as_float(((hy) & 0xffff0000u) | (((l) >> 16) & 0xff00u) | 0x80u)}
    f32x4 lg[8], lb[8];
#pragma unroll
    for (int j = 0; j < 8; ++j) { const int c = LN_C(j); lg[j] = *(const GAS f32x4*)(lng + c); lb[j] = *(const GAS f32x4*)(lnb + c); }
    struct Raw { v4u xh[4]; v2u xl[4]; f32x4 xf[8]; v4u y[4]; };
    auto fetch = [&](Raw& w, const int row) {
        const bf16* yr = Y + (size_t)row * D;
#pragma unroll
        for (int jj = 0; jj < 4; ++jj) { const int c2 = 8 * lane + 512 * jj;
            if (IN3) { w.xh[jj] = __builtin_nontemporal_load((const GAS v4u*)(XH + (size_t)row * D + c2)); w.xl[jj] = *(const GAS v2u*)(XL + (size_t)row * D + c2); }
            else { const float* xi = row < ML ? xin_lat + (size_t)row * D : xin_ctx + (size_t)(row - ML) * D; w.xf[2 * jj] = __builtin_nontemporal_load((const GAS f32x4*)(xi + c2)); w.xf[2 * jj + 1] = __builtin_nontemporal_load((const GAS f32x4*)(xi + c2 + 4)); }
            w.y[jj] = __builtin_nontemporal_load((const GAS v4u*)(yr + c2)); } };
    Raw cur;
    if (gw < nrows) fetch(cur, gw);
    for (int row = gw; row < nrows; row += NGW) {
        const int rr = row < ML ? (row >> 12) : 4;
        float* xo = row < ML ? xout_lat + (size_t)row * D : xout_ctx + (size_t)(row - ML) * D;
        const float* g0 = gate + (size_t)rr * NMODC;
        f32x4 za[8]; v4u ya[4];
#pragma unroll
        for (int jj = 0; jj < 4; ++jj) {
            if (IN3) { za[2 * jj] = LN_DEC(cur.xh[jj].x, cur.xh[jj].y, cur.xl[jj].x); za[2 * jj + 1] = LN_DEC(cur.xh[jj].z, cur.xh[jj].w, cur.xl[jj].y); }
            else { za[2 * jj] = cur.xf[2 * jj]; za[2 * jj + 1] = cur.xf[2 * jj + 1]; }
            ya[jj] = cur.y[jj]; }
        { const int rown = row + NGW; if (rown < nrows) fetch(cur, rown); }
        float sa = 0.f;
#pragma unroll
        for (int j = 0; j < 8; ++j) { const int c = LN_C(j); const f32x4 ga = *(const GAS f32x4*)(g0 + c);
            const unsigned ya0 = (j & 1) ? ya[j >> 1].z : ya[j >> 1].x, ya1 = (j & 1) ? ya[j >> 1].w : ya[j >> 1].y;
            za[j] = ALPHA * za[j] + s * ga * (f32x4){bflo(ya0), bfhi(ya0), bflo(ya1), bfhi(ya1)};
            sa += (za[j][0] + za[j][1]) + (za[j][2] + za[j][3]); }
#pragma unroll
        for (int o = 1; o < 64; o <<= 1) sa += __builtin_bit_cast(float, __builtin_amdgcn_ds_bpermute((lane ^ o) << 2, __builtin_bit_cast(int, sa)));
        const float ma = sa * (1.0f / D); float qa = 0.f;
#pragma unroll
        for (int j = 0; j < 8; ++j) { za[j] = za[j] - ma; qa += (za[j][0] * za[j][0] + za[j][1] * za[j][1]) + (za[j][2] * za[j][2] + za[j][3] * za[j][3]); }
#pragma unroll
        for (int o = 1; o < 64; o <<= 1) qa += __builtin_bit_cast(float, __builtin_amdgcn_ds_bpermute((lane ^ o) << 2, __builtin_bit_cast(int, qa)));
        const float rs = 1.0f / sqrtf(qa * (1.0f / D) + LN_EPS);
#pragma unroll
        for (int jj = 0; jj < 4; ++jj) { const int c2 = 8 * lane + 512 * jj;
            const f32x4 xa = za[2 * jj] * rs * lg[2 * jj] + lb[2 * jj], xb = za[2 * jj + 1] * rs * lg[2 * jj + 1] + lb[2 * jj + 1];
            if (OUT3) { const float x0 = xa[0], x1 = xa[1], x2 = xa[2], x3 = xa[3], x4 = xb[0], x5 = xb[1], x6 = xb[2], x7 = xb[3];
                const unsigned b0 = __float_as_uint(x0), b1 = __float_as_uint(x1), b2 = __float_as_uint(x2), b3 = __float_as_uint(x3), b4 = __float_as_uint(x4), b5 = __float_as_uint(x5), b6 = __float_as_uint(x6), b7 = __float_as_uint(x7);
                v4u hw; hw.x = (b0 >> 16) | (b1 & 0xffff0000u); hw.y = (b2 >> 16) | (b3 & 0xffff0000u); hw.z = (b4 >> 16) | (b5 & 0xffff0000u); hw.w = (b6 >> 16) | (b7 & 0xffff0000u);
                v2u lw; lw.x = ((b0 >> 8) & 0xffu) | (b1 & 0xff00u) | ((b2 << 8) & 0xff0000u) | ((b3 << 16) & 0xff000000u); lw.y = ((b4 >> 8) & 0xffu) | (b5 & 0xff00u) | ((b6 << 8) & 0xff0000u) | ((b7 << 16) & 0xff000000u);
                *(GAS v4u*)(XH + (size_t)row * D + c2) = hw; *(GAS v2u*)(XL + (size_t)row * D + c2) = lw; }
            else { *(GAS f32x4*)(xo + c2) = xa; *(GAS f32x4*)(xo + c2 + 4) = xb; }
            if (nsh) { const f32x4 sh0 = *(const GAS f32x4*)(nsh + (size_t)rr * NMODC + c2), sc0 = *(const GAS f32x4*)(nsc + (size_t)rr * NMODC + c2), sh1 = *(const GAS f32x4*)(nsh + (size_t)rr * NMODC + c2 + 4), sc1 = *(const GAS f32x4*)(nsc + (size_t)rr * NMODC + c2 + 4);
                const f32x4 h0 = xa * (1.0f + sc0) + sh0, h1 = xb * (1.0f + sc1) + sh1;
                v4u w; w.x = cvt_pk_bf16(h0[0], h0[1]); w.y = cvt_pk_bf16(h0[2], h0[3]); w.z = cvt_pk_bf16(h1[0], h1[1]); w.w = cvt_pk_bf16(h1[2], h1[3]); *(GAS v4u*)(H + (size_t)row * D + c2) = w; } }
    }
#undef LN_C
#undef LN_DEC
}

#define OPAQUE_S(x) asm volatile("" : "+s"(x))
#define PH_BEGIN() unsigned _sz; asm volatile("s_mov_b32 %0, 0" : "=s"(_sz)); int _vz; asm volatile("v_mov_b32 %0, 0" : "=v"(_vz)); \
    const Args* ap = (const Args*)((const char*)&args + _sz); unsigned char* wsp = ap->ws; int tid = wv0 * 64 + (int)__builtin_amdgcn_mbcnt_hi(~0u, __builtin_amdgcn_mbcnt_lo(~0u, (unsigned)_vz)); const int G = ap->grid; \
    const int bx = (int)blockIdx.x + (int)_sz, lane = tid & 63, wave = __builtin_amdgcn_readfirstlane(tid >> 6); const int vcu = (G % 8 == 0) ? (bx % 8) * (G / 8) + bx / 8 : bx; \
    const int gw = vcu * NWAVES + wave, NGW = G * NWAVES, gtid = vcu * (NWAVES * 64) + tid, NT = G * NWAVES * 64; (void)lane; (void)gw; (void)NGW; (void)gtid; (void)NT; (void)bx
#define GRID_BAR() do { unsigned _bz; asm volatile("s_mov_b32 %0, 0" : "=s"(_bz)); unsigned* _bp = (unsigned*)(args.ws + WS_CTL) + CW_BAR + _bz; XcdBarrier _b; _b.bar = _bp; _b.x = xb_xcc_id() + _bz; _b.G = (unsigned)((const Args*)((const char*)&args + _bz))->grid; \
        _b.st = (volatile LAS unsigned*)(lds + MISC_OFF) + 8; int _bv; asm volatile("v_mov_b32 %0, 0" : "=v"(_bv)); \
        xcd_barrier(_b, (wv0 * 64 + (int)__builtin_amdgcn_mbcnt_hi(~0u, __builtin_amdgcn_mbcnt_lo(~0u, (unsigned)_bv))) == 0); } while (0)

#define MODP ((float*)(wsp + WS_S0 + 9 * SLOT))
#define MOD ((float*)(wsp + WS_MOD))
#define AGG ((float*)(wsp + WS_AGG))
#define XCTX ((float*)(wsp + WS_XCTX))
#define SLOTP(k) ((bf16*)(wsp + WS_S0 + (size_t)(k) * SLOT))
#define Hb ((bf16*)(wsp + WS_H))
#define Yb ((bf16*)(wsp + WS_Y))
#define S0 SLOTP(0)
#define RGX SLOTP(0)
#define GG SLOTP(1)
#define SCB SLOTP(2)
#define SCX SLOTP(3)
#define SGR SLOTP(4)
#define SGS SLOTP(5)
#define XC SLOTP(6)
#define ASC SLOTP(7)
#define LAF SLOTP(8)
#define VF SLOTP(9)
#define LAB Hb
#define VB Yb
#define HLF SLOTP(0)
#define HLB SLOTP(2)
#define PF SLOTP(3)
#define PB SLOTP(6)
#define ARG SLOTP(2)
#define T1 SLOTP(9)
#define MG SLOTP(0)
#define ACT SLOTP(0)
#define PART3 ((float*)SLOTP(2))
#define PART5 ((float*)SLOTP(8))
#define PARTF ((float*)SLOTP(4))
#define MODL (MOD + (size_t)l * 5 * NMODC)

template <int LAYER, int HALF> __device__ __forceinline__ void ffn_block(const Args& args, LAS unsigned char* lds, const int wv0) {
    constexpr int l = LAYER, half = HALF;
            const int sub = half * 2;
#ifndef SKIP_FUP
            { PH_BEGIN(); pg8::Gemm g{Hb, (const bf16*)(wsp + (half ? W_2IN : W_1IN))}; pg8::Sched<2 * DFF / 256> S; S.init(G, bx, (l == DEPTH - 1 && half == 1) ? ML / 256 : NPAN);
              pg8::EpiSwiGLU E{ACT, DFF};
              pg8::gemm_phase<pg8::EpiSwiGLU, true, D, D, D, 0, 0, 0>(lds + RING_OFF, g, S, E, tid);
              if (l == 0) {
                  const int ntile = NPAN * (2 * DFF / 256), nbusy = ntile - (ntile / G) * G;
                  if (nbusy > 0 && bx >= nbusy) { asm volatile("s_waitcnt vmcnt(0)" ::: "memory"); __syncthreads();
                      convert_weights(*ap, half == 0 ? 0 : 1, half == 0 ? CV_FIRST : 0, (half == 0 ? CV_FIRST : 0) + CV_UP, 0, wsp, lds, (bx - nbusy) * NWAVES + wave, (G - nbusy) * NWAVES, wave, lane); } } }
            GRID_BAR();
#endif
#ifndef SKIP_FDN
            { PH_BEGIN(); pg8::Gemm g{ACT, (const bf16*)(wsp + (half ? (l == DEPTH - 1 ? W_2OUT_ALT : W_2OUT) : W_1OUT))}; pg8::Sched<D / 256> S; S.init(G, bx, ML / 256);
              pg8::EpiPlain E{Yb, D};
              pg8::gemm_phase<pg8::EpiPlain, true, DFF, DFF, DFF, 0, 0, 0>(lds + RING_OFF, g, S, E, tid); }
            if (!(l == DEPTH - 1 && half == 1)) {
              PH_BEGIN(); pg8::Gemm g2{ACT + (size_t)ML * DFF, (const bf16*)(wsp + (half ? W_2OUT : W_1OUT))}; pg8::Sched<32> S2; S2.init(G, bx, MC / 256);
              pg8::EpiPartial<false> E2{PARTF, nullptr, ML};
              pg8::gemm_phase<pg8::EpiPartial<false>, true, DFF, DFF, DFF / 4, 8, DFF / 4, 8>(lds + RING_OFF, g2, S2, E2, tid); }
            if (l == 0) {
              PH_BEGIN(); __syncthreads();
              const int nsplit = (MC / 256) * 32 < G ? (MC / 256) * 32 : G;
              const int NW = (nsplit + 2 * (G - nsplit)) * NWAVES;
              const int lo = (half == 0 ? CV_FIRST : 0) + CV_UP, lyr = half == 0 ? 0 : 1, alt = half == 0 ? 0 : 1;
              if (bx < nsplit) convert_weights(*ap, lyr, lo, CV_ALL, alt, wsp, lds, bx * NWAVES + wave, NW, wave, lane);
              else { const int w0 = nsplit * NWAVES + ((bx - nsplit) * NWAVES + wave) * 2;
                  convert_weights(*ap, lyr, lo, CV_ALL, alt, wsp, lds, w0, NW, wave, lane); convert_weights(*ap, lyr, lo, CV_ALL, alt, wsp, lds, w0 + 1, NW, wave, lane); } }
            GRID_BAR();
#endif
#ifndef SKIP_LNF
            { PH_BEGIN(); const bool first = (l == 0 && half == 0);
              const float* nsh = nullptr; const float* nsc = nullptr;
              if (half == 0) { nsh = MODL + 3 * D; nsc = MODL + 4 * D; } else if (l + 1 < DEPTH) { nsh = MODL + 5 * NMODC; nsc = MODL + 5 * NMODC + D; }
              ln_phase<!(LAYER == 0 && HALF == 0), !(LAYER == DEPTH - 1 && HALF == 1)>(ap->in[I_X], ap->in[I_CTX], ap->out, nullptr, (unsigned short*)(wsp + WS_XHI), wsp + WS_XLO, Yb, MODL + (2 + 3 * sub) * D, 0.5f,
                       ap->in[I_LNG] + (size_t)(l * 3 + sub) * D, ap->in[I_LNB] + (size_t)(l * 3 + sub) * D, nsh, nsc, Hb, gw, NGW, lane, (l == DEPTH - 1 && half == 1) ? ML : M, (l == DEPTH - 1 && half == 1) ? (const float*)nullptr : (const float*)PARTF); }
            if (!(l == DEPTH - 1 && half == 1)) GRID_BAR();
#endif
}


constexpr int RG_PITCH = 272, RG_T_OFF = 256 * RG_PITCH;
typedef short rg_bf16x8 __attribute__((ext_vector_type(8)));
struct RgAcc { f32x4 xr, xi, uu; };
__device__ __forceinline__ RgAcc rg_mma(LAS unsigned char* lds, const int m, const rg_bf16x8 (&Br)[4], const rg_bf16x8 (&Bi)[4], const rg_bf16x8 Bid, const int wave, const int q, const int cl) {
    typedef rg_bf16x8 bf16x8;
    bf16x8 a[4];
#pragma unroll
    for (int ks = 0; ks < 4; ++ks) a[ks] = *(const LAS bf16x8*)(lds + (16 * m + cl) * RG_PITCH + 64 * ks + 16 * q);
    const bf16x8 au = *(const LAS bf16x8*)(lds + (16 * m + cl) * RG_PITCH + 64 * (wave >> 1) + 16 * q);
    RgAcc r; r.xr = (f32x4){0.f, 0.f, 0.f, 0.f}; r.xi = r.xr;
#pragma unroll
    for (int ks = 0; ks < 4; ++ks) { r.xr = __builtin_amdgcn_mfma_f32_16x16x32_bf16(a[ks], Br[ks], r.xr, 0, 0, 0); r.xi = __builtin_amdgcn_mfma_f32_16x16x32_bf16(a[ks], Bi[ks], r.xi, 0, 0, 0); }
    r.uu = __builtin_amdgcn_mfma_f32_16x16x32_bf16(au, Bid, (f32x4){0.f, 0.f, 0.f, 0.f}, 0, 0, 0);
    return r;
}
struct RgGate { float ea[4], vv[4]; };
typedef float rg_f32x2 __attribute__((ext_vector_type(2)));
__device__ __forceinline__ RgGate rg_act(const RgAcc& c, const float nbr, const float nbi, const float ls2) {
    constexpr float LOG2E = 1.4426950408889634f;
    RgGate g;
#pragma unroll
    for (int h = 0; h < 2; ++h) {
        const rg_f32x2 xr = {c.xr[2 * h], c.xr[2 * h + 1]}, xi = {c.xi[2 * h], c.xi[2 * h + 1]}, uu = {c.uu[2 * h], c.uu[2 * h + 1]};
        const rg_f32x2 tr = xr * (-LOG2E) + nbr, ti = xi * (-LOG2E) + nbi;
        rg_f32x2 er = {__builtin_amdgcn_exp2f(tr.x), __builtin_amdgcn_exp2f(tr.y)}, ei = {__builtin_amdgcn_exp2f(ti.x), __builtin_amdgcn_exp2f(ti.y)};
        er = er + 1.0f; ei = ei + 1.0f;
        const rg_f32x2 rg = {__builtin_amdgcn_rcpf(er.x), __builtin_amdgcn_rcpf(er.y)}, ig = {__builtin_amdgcn_rcpf(ei.x), __builtin_amdgcn_rcpf(ei.y)};
        const rg_f32x2 la = rg * ls2;
        const rg_f32x2 e = {__builtin_amdgcn_exp2f(la.x), __builtin_amdgcn_exp2f(la.y)};
        const rg_f32x2 om = 1.0f - e * e;
        const rg_f32x2 sq = {__builtin_amdgcn_sqrtf(om.x), __builtin_amdgcn_sqrtf(om.y)};
        const rg_f32x2 v = sq * (ig * uu);
        g.ea[2 * h] = e.x; g.ea[2 * h + 1] = e.y; g.vv[2 * h] = v.x; g.vv[2 * h + 1] = v.y; }
    return g;
}
constexpr int CW_T1F = 800;
constexpr int CW_RGF = 512;
template <int d> __device__ __forceinline__ void rg_scan1(const bool add, const RgGate& g, float& hin, float& Acum, unsigned& P01, unsigned& P23, unsigned& H01, unsigned& H23, const int lane, const int q, const int cl) {
    const int s1 = (d ? lane + 16 : lane - 16) & 63, s2 = (d ? lane + 32 : lane - 32) & 63, st = d ? cl : 48 + cl;
    const bool v1 = d ? (q < 3) : (q >= 1), v2 = d ? (q < 2) : (q >= 2);
    const int f0 = d ? 3 : 0, f1 = d ? 2 : 1, f2 = d ? 1 : 2, f3 = d ? 0 : 3;
    float A = g.ea[f0] * g.ea[f1], H = g.ea[f1] * g.vv[f0] + g.vv[f1];
    A *= g.ea[f2]; H = g.ea[f2] * H + g.vv[f2]; A *= g.ea[f3]; H = g.ea[f3] * H + g.vv[f3];
#define RG_BP(src, x) __builtin_bit_cast(float, __builtin_amdgcn_ds_bpermute((src) << 2, __builtin_bit_cast(int, (x))))
    float Ap = RG_BP(s1, A), Hp = RG_BP(s1, H); if (!v1) { Ap = 1.f; Hp = 0.f; }
    const float A1 = A * Ap, H1 = A * Hp + H;
    float Ap2 = RG_BP(s2, A1), Hp2 = RG_BP(s2, H1); if (!v2) { Ap2 = 1.f; Hp2 = 0.f; }
    const float A2 = A1 * Ap2, H2 = A1 * Hp2 + H1;
    float Ae = RG_BP(s1, A2), He = RG_BP(s1, H2); if (!v1) { Ae = 1.f; He = 0.f; }
    const float At = RG_BP(st, A2), Ht = RG_BP(st, H2);
#undef RG_BP
    float hs = Ae * hin + He, pc = Ae * Acum;
    float ho[4], po[4];
    hs = g.ea[f0] * hs + g.vv[f0]; ho[f0] = hs; pc *= g.ea[f0]; po[f0] = pc;
    hs = g.ea[f1] * hs + g.vv[f1]; ho[f1] = hs; pc *= g.ea[f1]; po[f1] = pc;
    hs = g.ea[f2] * hs + g.vv[f2]; ho[f2] = hs; pc *= g.ea[f2]; po[f2] = pc;
    hs = g.ea[f3] * hs + g.vv[f3]; ho[f3] = hs; pc *= g.ea[f3]; po[f3] = pc;
    P01 = cvt_pk_bf16(po[0], po[1]); P23 = cvt_pk_bf16(po[2], po[3]);
    asm volatile("" : "+v"(P01), "+v"(P23));
    if (add) { ho[0] += bflo(H01); ho[1] += bfhi(H01); ho[2] += bflo(H23); ho[3] += bfhi(H23); }
    H01 = cvt_pk_bf16(ho[0], ho[1]); H23 = cvt_pk_bf16(ho[2], ho[3]);
    asm volatile("" : "+v"(H01), "+v"(H23));
    hin = At * hin + Ht; Acum *= At;
}
template <int LAYER, int NTL> __device__ __forceinline__ void rg_unit(const Args& args, LAS unsigned char* lds, const int wv0, v4u (&xw)[NTL / 2],
                                                                       const int row0, const int hd, const int b, const int ci, const int pf, const int pb, const int g, const bool has_next, const int row0n, const int hdn) {
    constexpr int l = LAYER;
    typedef rg_bf16x8 bf16x8;
    constexpr float LOG2E = 1.4426950408889634f;
    constexpr bool CTX = NTL == 4;
    PH_BEGIN();
    const int q = lane >> 4, cl = lane & 15;
    const float* gbl = ap->in[I_RGGB] + (size_t)l * 4 * D;
    const float* ls8l = (const float*)(wsp + WS_LS8) + (size_t)l * 2 * D;
    unsigned* flgL = (unsigned*)(wsp + WS_CTL) + CW_RGF + l * 128;
    unsigned* flgC = flgL + 64;
    unsigned* bar = (unsigned*)(wsp + WS_CTL) + CW_BAR;
    const int r0x = tid >> 4, c16x = tid & 15, vxx = (r0x * D + c16x * 8) * 2;
    const int chl = wave * 16 + cl, ch = hd * 128 + chl;
    __syncthreads();
#pragma unroll
    for (int i = 0; i < NTL / 2; ++i) *(LAS v4u*)(lds + (r0x + 32 * i) * RG_PITCH + c16x * 16) = xw[i];
    bf16x8 Bid;
    { const int kl = 16 * (wave & 1) + cl; const bool mine = (kl >> 3) == q;
#pragma unroll
      for (int jj = 0; jj < 8; ++jj) Bid[jj] = (mine && (kl & 7) == jj) ? (short)0x3F80 : (short)0; }
    const bf16* wg = (const bf16*)(wsp + W_G2) + ((size_t)((hd * 2) * 256) + chl) * 128 + 8 * q;
    const float nbr0 = -LOG2E * gbl[(size_t)0 * D + ch], nbi0 = -LOG2E * gbl[(size_t)1 * D + ch], ls20 = LOG2E * ls8l[ch];
    const float nbr1 = -LOG2E * gbl[(size_t)2 * D + ch], nbi1 = -LOG2E * gbl[(size_t)3 * D + ch], ls21 = LOG2E * ls8l[(size_t)D + ch];
    bf16x8 Br[4], Bi[4];
#pragma unroll
    for (int ks = 0; ks < 4; ++ks) { Br[ks] = *(const GAS bf16x8*)(wg + 32 * ks); Bi[ks] = *(const GAS bf16x8*)(wg + 128 * 128 + 32 * ks); }
    __syncthreads();
    unsigned Pf[NTL][2], Pb[NTL][2], Hs[NTL][2];
    float hin0 = 0.f, hin1 = 0.f, Ls0 = 1.f, Ls1 = 1.f;
    if (wave >= 4) __builtin_amdgcn_s_sleep(8);
    {
        RgAcc acc = rg_mma(lds, 0, Br, Bi, Bid, wave, q, cl);
#pragma unroll
        for (int mm = 0; mm < NTL; ++mm) {
            RgAcc nxt = acc;
            if (mm < NTL - 1) nxt = rg_mma(lds, mm + 1, Br, Bi, Bid, wave, q, cl);
            const RgGate fa = rg_act(acc, nbr0, nbi0, ls20);
            rg_scan1<0>(false, fa, hin0, Ls0, Pf[mm][0], Pf[mm][1], Hs[mm][0], Hs[mm][1], lane, q, cl);
            asm volatile("" ::: "memory"); __builtin_amdgcn_sched_barrier(0);
            acc = nxt;
        }
    }
#pragma unroll
    for (int ks = 0; ks < 4; ++ks) { Br[ks] = *(const GAS bf16x8*)(wg + 256 * 128 + 32 * ks); Bi[ks] = *(const GAS bf16x8*)(wg + 256 * 128 + 128 * 128 + 32 * ks); }
    {
        RgAcc acc = rg_mma(lds, NTL - 1, Br, Bi, Bid, wave, q, cl);
#pragma unroll
        for (int mm = 0; mm < NTL; ++mm) {
            RgAcc nxt = acc;
            if (mm < NTL - 1) nxt = rg_mma(lds, NTL - 2 - mm, Br, Bi, Bid, wave, q, cl);
            const RgGate fb = rg_act(acc, nbr1, nbi1, ls21);
            rg_scan1<1>(true, fb, hin1, Ls1, Pb[NTL - 1 - mm][0], Pb[NTL - 1 - mm][1], Hs[NTL - 1 - mm][0], Hs[NTL - 1 - mm][1], lane, q, cl);
            asm volatile("" ::: "memory"); __builtin_amdgcn_sched_barrier(0);
            acc = nxt;
        }
    }
    if (q == 0) { __hip_atomic_store(&AGG[(size_t)((ci * 2 + 0) * 2) * D + ch], Ls0, __ATOMIC_RELAXED, __HIP_MEMORY_SCOPE_AGENT); __hip_atomic_store(&AGG[(size_t)((ci * 2 + 0) * 2 + 1) * D + ch], hin0, __ATOMIC_RELAXED, __HIP_MEMORY_SCOPE_AGENT);
        __hip_atomic_store(&AGG[(size_t)((ci * 2 + 1) * 2) * D + ch], Ls1, __ATOMIC_RELAXED, __HIP_MEMORY_SCOPE_AGENT); __hip_atomic_store(&AGG[(size_t)((ci * 2 + 1) * 2 + 1) * D + ch], hin1, __ATOMIC_RELAXED, __HIP_MEMORY_SCOPE_AGENT); }
    asm volatile("s_waitcnt vmcnt(0)" ::: "memory");
    __syncthreads();
    if (tid == 0) (void)xb_add(CTX ? &flgC[g] : &flgL[g], 1u);
    const bool need_out = !(l == DEPTH - 1 && CTX);
    if (has_next) { const __amdgpu_buffer_rsrc_t rX = __builtin_amdgcn_make_buffer_rsrc((void*)(XC + (size_t)row0n * D + hdn * 128), 0, 16 * NTL * D * 2, 0x00020000);
#pragma unroll
        for (int i = 0; i < NTL / 2; ++i) xw[i] = __builtin_amdgcn_raw_buffer_load_b128(rX, vxx, (32 * i * D) * 2, 0); }
    const int vgo = vxx;
    v4u ggw[NTL / 2];
    if (need_out) { const __amdgpu_buffer_rsrc_t rG = __builtin_amdgcn_make_buffer_rsrc((void*)(GG + (size_t)row0 * D + hd * 128), 0, 16 * NTL * D * 2, 0x00020000);
#pragma unroll
        for (int i = 0; i < NTL / 2; ++i) ggw[i] = __builtin_amdgcn_raw_buffer_load_b128(rG, vgo, (32 * i * D) * 2, 0); }
    if (need_out) {
        if (tid == 0) { if (!CTX) XB_SPIN(xb_ld(&flgL[g]) < 16u, bar); XB_SPIN(xb_ld(&flgC[g]) < 4u, bar); __builtin_amdgcn_fence(__ATOMIC_ACQUIRE, "agent"); asm volatile("s_waitcnt vmcnt(0)" ::: "memory"); }
        __syncthreads();
        constexpr int NFOLD = CTX ? 3 : 19;
        const int dd = q & 1, mypos = dd ? pb : pf;
        const __amdgpu_buffer_rsrc_t rA = __builtin_amdgcn_make_buffer_rsrc((void*)AGG, 0, 80 * 4 * D * 4, 0x00020000);
        const int va = (dd * 2 * D + ch) * 4;
        float Lc[NFOLD], Hc[NFOLD];
#pragma unroll
        for (int t = 0; t < NFOLD; ++t) { const int cfw = (t < 4) ? 64 + 4 * b + t : 16 * b + (t - 4), cbw = (t < 4) ? 64 + 4 * b + (3 - t) : 16 * b + (19 - t);
            const int vo = va + (dd ? cbw : cfw) * (4 * D * 4); const bool ok = t < mypos;
            const float lv = __builtin_bit_cast(float, __builtin_amdgcn_raw_buffer_load_b32(rA, vo, 0, 0)), hv = __builtin_bit_cast(float, __builtin_amdgcn_raw_buffer_load_b32(rA, vo, D * 4, 0));
            Lc[t] = ok ? lv : 1.f; Hc[t] = ok ? hv : 0.f; }
        float c = 0.f;
#pragma unroll
        for (int t = 0; t < NFOLD; ++t) c = Lc[t] * c + Hc[t];
        const float cf = __builtin_bit_cast(float, __builtin_amdgcn_ds_bpermute(cl << 2, __builtin_bit_cast(int, c)));
        const float cb = __builtin_bit_cast(float, __builtin_amdgcn_ds_bpermute((16 + cl) << 2, __builtin_bit_cast(int, c)));
#pragma unroll
        for (int m = 0; m < NTL; ++m) {
#pragma unroll
            for (int k = 0; k < 2; ++k) { const unsigned pfw = Pf[m][k], pbw = Pb[m][k], hh = Hs[m][k];
                Hs[m][k] = cvt_pk_bf16(bflo(hh) + bflo(pfw) * cf + bflo(pbw) * cb, bfhi(hh) + bfhi(pfw) * cf + bfhi(pbw) * cb); } }
#pragma unroll
        for (int m = 0; m < NTL; ++m) {
#pragma unroll
            for (int k = 0; k < 2; ++k) { LAS unsigned short* t0 = (LAS unsigned short*)(lds + RG_T_OFF + (16 * m + 4 * q + 2 * k) * RG_PITCH + chl * 2); LAS unsigned short* t1 = (LAS unsigned short*)(lds + RG_T_OFF + (16 * m + 4 * q + 2 * k + 1) * RG_PITCH + chl * 2);
                const unsigned w = Hs[m][k]; *t0 = (unsigned short)(w & 0xffffu); *t1 = (unsigned short)(w >> 16); } }
        __syncthreads();
        const __amdgpu_buffer_rsrc_t rO = __builtin_amdgcn_make_buffer_rsrc((void*)(ARG + (size_t)row0 * D + hd * 128), 0, 16 * NTL * D * 2, 0x00020000);
#pragma unroll
        for (int i = 0; i < NTL / 2; ++i) { const int r = r0x + 32 * i;
            const v4u hw = *(const LAS v4u*)(lds + RG_T_OFF + r * RG_PITCH + c16x * 16), gw = ggw[i];
            v4u o; o.x = cvt_pk_bf16(bflo(hw.x) * bflo(gw.x), bfhi(hw.x) * bfhi(gw.x)); o.y = cvt_pk_bf16(bflo(hw.y) * bflo(gw.y), bfhi(hw.y) * bfhi(gw.y));
            o.z = cvt_pk_bf16(bflo(hw.z) * bflo(gw.z), bfhi(hw.z) * bfhi(gw.z)); o.w = cvt_pk_bf16(bflo(hw.w) * bflo(gw.w), bfhi(hw.w) * bfhi(gw.w));
            __builtin_amdgcn_raw_buffer_store_b128(o, rO, vgo, (32 * i * D) * 2, 0); }
    }
}
template <int LAYER> __device__ __forceinline__ void rg_phase1(const Args& args, LAS unsigned char* lds, const int wv0) {
    unsigned _sz; asm volatile("s_mov_b32 %0, 0" : "=s"(_sz));
    const int bx = (int)blockIdx.x + (int)_sz;
    int _vz; asm volatile("v_mov_b32 %0, 0" : "=v"(_vz));
    const int tid = wv0 * 64 + (int)__builtin_amdgcn_mbcnt_hi(~0u, __builtin_amdgcn_mbcnt_lo(~0u, (unsigned)_vz));
    unsigned char* wsp = ((const Args*)((const char*)&args + _sz))->ws;
    const int r0x = tid >> 4, c16x = tid & 15, vxx = (r0x * D + c16x * 8) * 2;
    const int gC = bx >> 2, kC = bx & 3, bC = gC >> 4, hdC = gC & 15, rowC = ML + bC * 256 + 64 * kC;
    const int slot = bx >> 4, mi = bx & 15;
    v4u xwC[2], xwL[8];
    { const __amdgpu_buffer_rsrc_t rX = __builtin_amdgcn_make_buffer_rsrc((void*)(XC + (size_t)rowC * D + hdC * 128), 0, 64 * D * 2, 0x00020000);
#pragma unroll
      for (int i = 0; i < 2; ++i) xwC[i] = __builtin_amdgcn_raw_buffer_load_b128(rX, vxx, (32 * i * D) * 2, 0); }
    { const int g = slot, b = g >> 4, hd = g & 15, p = 16 * b + mi;
      const __amdgpu_buffer_rsrc_t rX = __builtin_amdgcn_make_buffer_rsrc((void*)(XC + (size_t)p * 256 * D + hd * 128), 0, 256 * D * 2, 0x00020000);
#pragma unroll
      for (int i = 0; i < 8; ++i) xwL[i] = __builtin_amdgcn_raw_buffer_load_b128(rX, vxx, (32 * i * D) * 2, 0); }
    rg_unit<LAYER, 4>(args, lds, wv0, xwC, rowC, hdC, bC, 64 + 4 * bC + kC, kC, 3 - kC, gC, false, 0, 0);
    for (int g = slot; g < 64; g += 16) {
        const int b = g >> 4, hd = g & 15, p = 16 * b + mi;
        const int g2 = g + 16, p2 = 16 * (g2 >> 4) + mi;
        rg_unit<LAYER, 16>(args, lds, wv0, xwL, p * 256, hd, b, p, 4 + mi, 19 - mi, g, g2 < 64, p2 * 256, g2 & 15);
    }
}

template <int LAYER> __device__ __forceinline__ void mixer_block(const Args& args, LAS unsigned char* lds, const int wv0) {
    constexpr int l = LAYER, half = 0; (void)half;
#ifndef SKIP_M1
            { PH_BEGIN(); pg8::Gemm g{Hb, (const bf16*)(wsp + W_IN)}; pg8::Sched<PROJ_W / 256> S; S.init(G, bx, NPAN);
              pg8::EpiProj E{S0, SLOT_ELEMS, ap->in[I_BMERGE] + (size_t)l * 2 * D};
              pg8::gemm_phase<pg8::EpiProj, true, D, D, D, 0, 0, 0>(lds + RING_OFF, g, S, E, tid); }
            GRID_BAR();
#endif
#ifndef SKIP_M2A
            {
                PH_BEGIN();
                const int cg = gtid & 255, ch = cg * 8;
                float wr_[4][8], ws_[3][8], bb[8];
                const float* rcw = ap->in[I_RGCW] + (size_t)l * 4 * D; const float* scw = ap->in[I_SCCW] + (size_t)l * 3 * D; const float* rcb = ap->in[I_RGCB] + (size_t)l * D;
#pragma unroll
                for (int j = 0; j < 8; ++j) { bb[j] = rcb[ch + j];
#pragma unroll
                    for (int k = 0; k < 4; ++k) wr_[k][j] = rcw[k * D + ch + j];
#pragma unroll
                    for (int k = 0; k < 3; ++k) ws_[k][j] = scw[k * D + ch + j]; }
                for (int rowA = gtid >> 8; rowA < M; rowA += NT >> 7) {
                    const int rowB = rowA + (NT >> 8); const bool two = rowB < M;
                    v4u xr[2][4], xs[2][3], bw[2]; const v4u zero4 = {(unsigned)_vz, (unsigned)_vz, (unsigned)_vz, (unsigned)_vz};
#pragma unroll
                    for (int t = 0; t < 2; ++t) { const int row = t ? (two ? rowB : rowA) : rowA;
                        int q0, q1; if (row < ML) { q0 = row & ~63; q1 = q0 + 64; } else { q0 = row & ~255; q1 = q0 + 256; }
#pragma unroll
                        for (int k = 0; k < 4; ++k) { const int rr = row + k - 2; xr[t][k] = (rr >= q0 && rr < q1) ? *(const GAS v4u*)(RGX + (size_t)rr * D + ch) : zero4; }
#pragma unroll
                        for (int k = 0; k < 3; ++k) { const int rr = row + k - 1; xs[t][k] = (rr >= q0 && rr < q1) ? *(const GAS v4u*)(SCX + (size_t)rr * D + ch) : zero4; }
                        bw[t] = *(const GAS v4u*)(SCB + (size_t)row * D + ch); }
#pragma unroll
                    for (int t = 0; t < 2; ++t) { if (t == 1 && !two) break; const int row = t ? rowB : rowA;
                        float a[8], c2[8];
#pragma unroll
                        for (int j = 0; j < 8; ++j) { a[j] = bb[j]; c2[j] = 0.f; }
#pragma unroll
                        for (int k = 0; k < 4; ++k) { const v4u xw = xr[t][k];
                            a[0] += wr_[k][0] * bflo(xw.x); a[1] += wr_[k][1] * bfhi(xw.x); a[2] += wr_[k][2] * bflo(xw.y); a[3] += wr_[k][3] * bfhi(xw.y);
                            a[4] += wr_[k][4] * bflo(xw.z); a[5] += wr_[k][5] * bfhi(xw.z); a[6] += wr_[k][6] * bflo(xw.w); a[7] += wr_[k][7] * bfhi(xw.w); }
#pragma unroll
                        for (int k = 0; k < 3; ++k) { const v4u xw = xs[t][k];
                            c2[0] += ws_[k][0] * bflo(xw.x); c2[1] += ws_[k][1] * bfhi(xw.x); c2[2] += ws_[k][2] * bflo(xw.y); c2[3] += ws_[k][3] * bfhi(xw.y);
                            c2[4] += ws_[k][4] * bflo(xw.z); c2[5] += ws_[k][5] * bfhi(xw.z); c2[6] += ws_[k][6] * bflo(xw.w); c2[7] += ws_[k][7] * bfhi(xw.w); }
                        v4u o; o.x = cvt_pk_bf16(a[0], a[1]); o.y = cvt_pk_bf16(a[2], a[3]); o.z = cvt_pk_bf16(a[4], a[5]); o.w = cvt_pk_bf16(a[6], a[7]);
                        *(GAS v4u*)(XC + (size_t)row * D + ch) = o;
                        o.x = cvt_pk_bf16(c2[0] * bflo(bw[t].x), c2[1] * bfhi(bw[t].x)); o.y = cvt_pk_bf16(c2[2] * bflo(bw[t].y), c2[3] * bfhi(bw[t].y));
                        o.z = cvt_pk_bf16(c2[4] * bflo(bw[t].z), c2[5] * bfhi(bw[t].z)); o.w = cvt_pk_bf16(c2[6] * bflo(bw[t].w), c2[7] * bfhi(bw[t].w));
                        *(GAS v4u*)(ASC + (size_t)row * D + ch) = o; }
                }
            }
            GRID_BAR();
#endif
            rg_phase1<LAYER>(args, lds, wv0);
            GRID_BAR();
#ifndef SKIP_M3
            { PH_BEGIN(); pg8::Gemm g{ARG, (const bf16*)(wsp + W_RG)}; pg8::SchedX<D / 256> S; S.init(G, bx, (l == DEPTH - 1) ? ML / 256 : NPAN, 0, nullptr, 0u);
              pg8::EpiGated<false> E{T1, SGR, nullptr, nullptr, 0};
              pg8::gemm_phase<pg8::EpiGated<false>, true, D, D, D, 0, 0, 0>(lds + RING_OFF, g, S, E, tid);
              asm volatile("s_waitcnt vmcnt(0)" ::: "memory"); __syncthreads();
              const int ntile = ((l == DEPTH - 1) ? ML / 256 : NPAN) * (D / 256), ntail = ntile - (ntile / G) * G;
              if (bx < ntail && tid == 0) { __builtin_amdgcn_fence(__ATOMIC_RELEASE, "agent"); asm volatile("s_waitcnt vmcnt(0)" ::: "memory"); (void)xb_add((unsigned*)(wsp + WS_CTL) + CW_T1F + l, 1u); } }
#endif
#ifndef SKIP_M4
            { PH_BEGIN(); const int ntile = ((l == DEPTH - 1) ? ML / 256 : NPAN) * (D / 256), ntail = ntile - (ntile / G) * G;
              pg8::Gemm g{ASC, (const bf16*)(wsp + W_SC)}; pg8::SchedX<D / 256> S; S.init(G, bx, (l == DEPTH - 1) ? ML / 256 : NPAN, (ntail > 0 && 2 * ntail <= G) ? ntail : 0, (unsigned*)(wsp + WS_CTL) + CW_T1F + l, (unsigned)ntail);
              pg8::EpiGated<true> E{MG, SGS, T1, (const float*)nullptr, ML};
              pg8::gemm_phase<pg8::EpiGated<true>, true, D, D, D, 0, 0, 0>(lds + RING_OFF, g, S, E, tid); }
            GRID_BAR();
#endif
#ifndef SKIP_M5
            { PH_BEGIN(); pg8::Gemm g{MG, (const bf16*)(wsp + W_O)}; pg8::Sched<D / 256> S; S.init(G, bx, ML / 256);
              pg8::EpiPlain E{Yb, D};
              pg8::gemm_phase<pg8::EpiPlain, true, D, D, D, 0, 0, 0>(lds + RING_OFF, g, S, E, tid); }
            if (l < DEPTH - 1) {
              PH_BEGIN(); pg8::Gemm g2{MG + (size_t)ML * D, (const bf16*)(wsp + W_O)}; pg8::Sched<32> S2; S2.init(G, bx, MC / 256);
              pg8::EpiPartial<false> E2{PART5, nullptr, ML};
              pg8::gemm_phase<pg8::EpiPartial<false>, true, D, D, D / 4, 8, D / 4, 8>(lds + RING_OFF, g2, S2, E2, tid); }
            GRID_BAR();
#endif
#ifndef SKIP_M6
            { PH_BEGIN();
            ln_phase<true, true>(nullptr, nullptr, nullptr, nullptr, (unsigned short*)(wsp + WS_XHI), wsp + WS_XLO, Yb, MODL + 5 * D, 1.0f, ap->in[I_LNG] + (size_t)(l * 3 + 1) * D, ap->in[I_LNB] + (size_t)(l * 3 + 1) * D,
                     MODL + 6 * D, MODL + 7 * D, Hb, gw, NGW, lane, (l == DEPTH - 1) ? ML : M, (l < DEPTH - 1) ? (const float*)PART5 : (const float*)nullptr); }
            GRID_BAR();
#endif
}

__global__ void __launch_bounds__(NWAVES * 64, 2) fwd_kernel(Args args) {
    extern __shared__ __attribute__((aligned(16))) unsigned char lds_raw[];
    LAS unsigned char* lds = (LAS unsigned char*)lds_raw;
    volatile LAS unsigned* MISC = (volatile LAS unsigned*)(lds + MISC_OFF);
    const int wv0 = __builtin_amdgcn_readfirstlane((int)threadIdx.x >> 6);
    for (int u = threadIdx.x; u < (LDS_BYTES - LDSCTL_OFF) / 4; u += NWAVES * 64) ((LAS unsigned*)(lds + LDSCTL_OFF))[u] = 0u;
    __syncthreads();
    (void)xcd_barrier_post((unsigned*)(args.ws + WS_CTL) + CW_BAR, MISC + 8);
#ifndef SKIP_P0
    {
        PH_BEGIN();
        LAS float* tab = (LAS float*)(lds + 69632);
        for (int i = tid; i < 5 * D; i += NWAVES * 64) { const int r = i >> 11, k = i & 2047; const float v = r < 4 ? ap->in[I_C][r * D + k] : ap->in[I_CCTX][k]; tab[i] = v * pg8::sigmoidf_(v); }
        __syncthreads();
        for (int it = gw; it < 144 * 16; it += NGW) {
            const int s = it & 15, g = it >> 4, l = g / 72, col = (g - l * 72) * 256 + lane * 4;
            const float* W = ap->in[I_WMOD] + (size_t)l * D * NMODC + (size_t)(s * 128) * NMODC + col;
            const LAS float* tb = tab + s * 128;
            f32x4 a0 = {0.f, 0.f, 0.f, 0.f}, a1 = a0, a2 = a0, a3 = a0, a4 = a0;
            for (int k = 0; k < 128; k += 16) { f32x4 w[16];
#pragma unroll
                for (int j = 0; j < 16; ++j) w[j] = *(const GAS f32x4*)(W + (size_t)(k + j) * NMODC);
#pragma unroll
                for (int j = 0; j < 16; ++j) { a0 += tb[k + j] * w[j]; a1 += tb[2048 + k + j] * w[j]; a2 += tb[4096 + k + j] * w[j]; a3 += tb[6144 + k + j] * w[j]; a4 += tb[8192 + k + j] * w[j]; } }
            float* o = MODP + (size_t)(s * 5) * (2 * NMODC) + l * NMODC + col;
            *(GAS f32x4*)o = a0; *(GAS f32x4*)(o + (size_t)2 * NMODC) = a1; *(GAS f32x4*)(o + (size_t)4 * NMODC) = a2; *(GAS f32x4*)(o + (size_t)6 * NMODC) = a3; *(GAS f32x4*)(o + (size_t)8 * NMODC) = a4;
        }
        for (int i = gtid; i < DEPTH * 2 * D; i += NT) { const float ex = __expf(-ap->in[I_RGLAM][i]);
            const float lp = ex < 0.05f ? ex * (1.0f - ex * (0.5f - ex * (0.33333333f - 0.25f * ex))) : __logf(1.0f + ex);
            ((float*)(wsp + WS_LS8))[i] = -8.0f * lp; }
        __syncthreads();
        convert_weights(*ap, 0, 0, CV_FIRST, 0, wsp, lds, gw, NGW, wave, lane);
    }
    GRID_BAR();
#endif
#ifndef SKIP_P1A
    { PH_BEGIN();
    for (int i = gtid; i < 2 * 5 * NMODC; i += NT) { const int n = i % NMODC, r = (i / NMODC) % 5, l = i / (5 * NMODC);
        float v = ap->in[I_BMOD][l * NMODC + n];
#pragma unroll
        for (int s = 0; s < 16; ++s) v += MODP[(size_t)(s * 5 + r) * (2 * NMODC) + l * NMODC + n];
        MOD[i] = v; } }
    GRID_BAR();
#endif
#ifndef SKIP_P1B
    { PH_BEGIN();
    for (int row = gw; row < M; row += NGW) {
        const int r = row < ML ? (row >> 12) : 4;
        const float* xi = row < ML ? ap->in[I_X] + (size_t)row * D : ap->in[I_CTX] + (size_t)(row - ML) * D;
        const float* sh = MOD + (size_t)r * NMODC; const float* sc = sh + D;
#pragma unroll
        for (int j = 0; j < 8; ++j) { const int c = 4 * lane + 256 * j; const f32x4 xv = *(const GAS f32x4*)(xi + c), s1 = *(const GAS f32x4*)(sh + c), s2 = *(const GAS f32x4*)(sc + c);
            const f32x4 hv = xv * (1.0f + s2) + s1; v2u w; w.x = cvt_pk_bf16(hv[0], hv[1]); w.y = cvt_pk_bf16(hv[2], hv[3]); *(GAS v2u*)(Hb + (size_t)row * D + c) = w; }
    } }
    GRID_BAR();
#endif
    ffn_block<0, 0>(args, lds, wv0); mixer_block<0>(args, lds, wv0); ffn_block<0, 1>(args, lds, wv0);
    ffn_block<1, 0>(args, lds, wv0); mixer_block<1>(args, lds, wv0); ffn_block<1, 1>(args, lds, wv0);
    { PH_BEGIN();
      if (xb_ld((unsigned*)(wsp + WS_CTL) + CW_BAR + XB_TMO) != 0u) { const float q = __builtin_nanf("");
          for (size_t i = (size_t)gtid; i < (size_t)ML * D; i += (size_t)NT) ap->out[i] = q; } }
}

#undef MODP
#undef MOD
#undef AGG
#undef XCTX
#undef SLOTP
#undef Hb
#undef Yb
#undef S0
#undef RGX
#undef GG
#undef SCB
#undef SCX
#undef SGR
#undef SGS
#undef XC
#undef ASC
#undef LAF
#undef VF
#undef LAB
#undef VB
#undef HLF
#undef HLB
#undef PF
#undef PB
#undef ARG
#undef T1
#undef MG
#undef ACT
#undef PART3
#undef PART5
#undef PARTF
#undef MODL
extern "C" void kernel_launch(void* const* d_in, const int* in_sizes, int n_in, void* d_out, int out_size, void* d_ws, size_t ws_size, hipStream_t stream) {
    static int grid = 0;
    if (grid == 0) {
        if (n_in != 23 || out_size != ML * D || ws_size < WS_END) { fprintf(stderr, "kernel_launch: unexpected shapes (n_in %d, out %d, ws %zu, need %zu); nothing launched\n", n_in, out_size, ws_size, (size_t)WS_END); grid = -1; return; }
        int dev = 0, cus = 0, per_cu = 0;
        if (hipGetDevice(&dev) != hipSuccess || hipDeviceGetAttribute(&cus, hipDeviceAttributeMultiprocessorCount, dev) != hipSuccess) { grid = -1; return; }
        if (hipFuncSetAttribute((const void*)fwd_kernel, hipFuncAttributeMaxDynamicSharedMemorySize, LDS_BYTES) != hipSuccess) { fprintf(stderr, "kernel_launch: hipFuncSetAttribute failed\n"); grid = -1; return; }
        if (hipOccupancyMaxActiveBlocksPerMultiprocessor(&per_cu, (const void*)fwd_kernel, NWAVES * 64, LDS_BYTES) != hipSuccess || per_cu < 1)
            fprintf(stderr, "kernel_launch: occupancy query reports %d workgroups per CU\n", per_cu);
        (void)hipGetLastError();
        grid = cus;
    }
    if (grid < 0) return;
    if (hipMemsetAsync((char*)d_ws + WS_CTL, 0, CTL_ZERO_BYTES, stream) != hipSuccess) return;
    Args a{};
    for (int i = 0; i < 23; ++i) a.in[i] = (const float*)d_in[i];
    a.out = (float*)d_out; a.ws = (unsigned char*)d_ws; a.grid = grid; a.pad = 0;
    hipLaunchKernelGGL(fwd_kernel, dim3(grid), dim3(NWAVES * 64), LDS_BYTES, stream, a);
    const hipError_t le = hipPeekAtLastError();
    if (le != hipSuccess) fprintf(stderr, "kernel_launch: launch failed: %s\n", hipGetErrorName(le));
}
```
